# Optimizing an MI355X kernel written in HIP

```python
import math
import jax, jax.numpy as jnp
from jax import lax
import numpy as np

D_MODEL = 1024
BATCH = 2
SEQ = 8192
DEPTH = 1

CHUNK = 64
CONV_CH = D_MODEL // 2
CONV_WIDTH = 31
RET_HEADS = 8
RET_DV = (D_MODEL // 2) // RET_HEADS
RET_DK = RET_DV // 2
D_MIX = CONV_CH + RET_HEADS * RET_DV
N_MEM = 256
XATTN_HEADS = 4
XATTN_HEAD_DIM = D_MODEL // XATTN_HEADS
D_FF = 4 * D_MODEL
ROPE_BASE = 10000.0
EPS = 1e-6

IN_SPLITS = (CONV_CH, CONV_CH, RET_HEADS * RET_DK, RET_HEADS * RET_DK, RET_HEADS * RET_DV, RET_HEADS * RET_DV)
D_IN = sum(IN_SPLITS)

kernel_name = "hybrid_conv_retention_memxattn_block"


def rmsnorm(x, w):
    xf = x.astype(jnp.float32)
    y = xf * lax.rsqrt(jnp.mean(xf * xf, axis=-1, keepdims=True) + EPS)
    return (y * w.astype(jnp.float32)).astype(x.dtype)


def apply_rotary(t, positions):
    half = t.shape[-1] // 2
    inv_freq = ROPE_BASE ** (-jnp.arange(half, dtype=jnp.float32) / half)
    ang = positions.astype(jnp.float32)[..., None] * inv_freq
    cos = jnp.cos(ang)[:, :, None, :]
    sin = jnp.sin(ang)[:, :, None, :]
    t1, t2 = t[..., :half].astype(jnp.float32), t[..., half:].astype(jnp.float32)
    return jnp.concatenate([t1 * cos - t2 * sin, t1 * sin + t2 * cos], axis=-1)


def conv_module(a, b, conv_w, conv_b, ln_w, ln_b):
    u = a * jax.nn.sigmoid(b)
    y = lax.conv_general_dilated(
        u, conv_w[:, None, :], window_strides=(1,), padding=[(CONV_WIDTH - 1, 0)],
        dimension_numbers=("NWC", "WIO", "NWC"), feature_group_count=CONV_CH) + conv_b
    yf = y.astype(jnp.float32)
    mu = jnp.mean(yf, axis=-1, keepdims=True)
    var = jnp.mean(jnp.square(yf - mu), axis=-1, keepdims=True)
    yn = (yf - mu) * lax.rsqrt(var + EPS) * ln_w + ln_b
    return jax.nn.silu(yn)


def retention(q, k, v, positions):
    B, S = q.shape[:2]
    N = S // CHUNK
    q = apply_rotary(q.reshape(B, S, RET_HEADS, RET_DK), positions) * (RET_DK ** -0.5)
    k = apply_rotary(k.reshape(B, S, RET_HEADS, RET_DK), positions)
    v = v.reshape(B, S, RET_HEADS, RET_DV).astype(jnp.float32)
    qc = q.reshape(B, N, CHUNK, RET_HEADS, RET_DK)
    kc = k.reshape(B, N, CHUNK, RET_HEADS, RET_DK)
    vc = v.reshape(B, N, CHUNK, RET_HEADS, RET_DV)

    log_g = jnp.log1p(-jnp.exp2(-5.0 - jnp.arange(RET_HEADS, dtype=jnp.float32)))
    idx = jnp.arange(CHUNK, dtype=jnp.float32)
    dist = jnp.abs(idx[:, None] - idx[None, :])
    decay_in = jnp.exp(log_g[:, None, None] * dist)
    zeta = jnp.exp(log_g[:, None] * (CHUNK - 1 - idx)[None, :])
    xi = jnp.exp(log_g[:, None] * (idx + 1.0)[None, :])
    g_chunk = jnp.exp(log_g * CHUNK)

    scores = jnp.einsum('bnihd,bnjhd->bnhij', qc, kc) * decay_in
    y_in = jnp.einsum('bnhij,bnjhe->bnihe', scores, vc)

    kv = jnp.einsum('bnjhd,bnjhe,hj->nbhde', kc, vc, zeta)

    def step(state, kv_n):
        return g_chunk[None, :, None, None] * state + kv_n, state

    init = jnp.zeros((B, RET_HEADS, RET_DK, RET_DV), jnp.float32)
    _, state_prev = lax.scan(step, init, kv)
    y_x = jnp.einsum('bnihd,nbhde,hi->bnihe', qc, state_prev, xi)
    return (y_in + y_x).reshape(B, S, RET_HEADS, RET_DV)


def head_group_mixer(h, positions, w_in, conv_w, conv_b, conv_ln_w, conv_ln_b, ret_gn_w, w_out):
    B, S, _ = h.shape
    proj = h @ w_in
    cuts = list(np.cumsum(IN_SPLITS)[:-1])
    ca, cb, rq, rk, rv, rg = jnp.split(proj, cuts, axis=-1)
    y_conv = conv_module(ca, cb, conv_w, conv_b, conv_ln_w, conv_ln_b)
    y = retention(rq, rk, rv, positions)
    mu = jnp.mean(y, axis=-1, keepdims=True)
    var = jnp.mean(jnp.square(y - mu), axis=-1, keepdims=True)
    y = (y - mu) * lax.rsqrt(var + EPS) * ret_gn_w.reshape(RET_HEADS, RET_DV)
    y_ret = jax.nn.silu(rg.astype(jnp.float32)) * y.reshape(B, S, RET_HEADS * RET_DV)
    merged = jnp.concatenate([y_conv, y_ret], axis=-1).astype(h.dtype)
    return merged @ w_out


def memory_cross_attention(h, mem_n, xq_w, xkv_w, xo_w):
    B, S, _ = h.shape
    q = (h @ xq_w).reshape(B, S, XATTN_HEADS, XATTN_HEAD_DIM)
    kv = (mem_n @ xkv_w).reshape(B, N_MEM, 2, XATTN_HEADS, XATTN_HEAD_DIM)
    k, v = kv[:, :, 0], kv[:, :, 1]
    s = jnp.einsum('bshd,bmhd->bhsm', q.astype(jnp.float32), k.astype(jnp.float32)) * (XATTN_HEAD_DIM ** -0.5)
    p = jax.nn.softmax(s, axis=-1)
    o = jnp.einsum('bhsm,bmhd->bshd', p, v.astype(jnp.float32)).reshape(B, S, D_MODEL)
    return o.astype(h.dtype) @ xo_w


def sq_relu_mlp(h, up_w, down_w):
    return jnp.square(jax.nn.relu(h @ up_w)) @ down_w


def setup_inputs(seed: int = 0) -> dict:
    key = jax.random.key(seed)
    ks = jax.random.split(key, 24)
    f32 = jnp.float32

    def w(k, shape, fan_in):
        return jax.random.normal(k, shape, f32) * (fan_in ** -0.5)

    def gain(k, n):
        return 1.0 + 0.02 * jax.random.normal(k, (n,), f32)

    x = jax.random.normal(ks[0], (BATCH, SEQ, D_MODEL), f32)
    mem = jax.random.normal(ks[1], (BATCH, N_MEM, D_MODEL), f32)
    start = jax.random.randint(ks[2], (BATCH, 1), 0, 1000, dtype=jnp.int32) * CHUNK
    positions = (start + jnp.arange(SEQ, dtype=jnp.int32)[None, :]).astype(jnp.int32)
    return {
        "x": x,
        "mem": mem,
        "positions": positions,
        "norm_mix_w": gain(ks[3], D_MODEL),
        "w_in": w(ks[4], (D_MODEL, D_IN), D_MODEL),
        "conv_w": w(ks[5], (CONV_WIDTH, CONV_CH), CONV_WIDTH),
        "conv_b": 0.02 * jax.random.normal(ks[6], (CONV_CH,), f32),
        "conv_ln_w": gain(ks[7], CONV_CH),
        "conv_ln_b": 0.02 * jax.random.normal(ks[8], (CONV_CH,), f32),
        "ret_gn_w": gain(ks[9], RET_HEADS * RET_DV),
        "w_out": w(ks[10], (D_MIX, D_MODEL), D_MIX),
        "norm_xattn_w": gain(ks[11], D_MODEL),
        "norm_mem_w": gain(ks[12], D_MODEL),
        "xq_w": w(ks[13], (D_MODEL, D_MODEL), D_MODEL),
        "xkv_w": w(ks[14], (D_MODEL, 2 * D_MODEL), D_MODEL),
        "xo_w": w(ks[15], (D_MODEL, D_MODEL), D_MODEL),
        "norm_mlp_w": gain(ks[16], D_MODEL),
        "mlp_up_w": w(ks[17], (D_MODEL, D_FF), D_MODEL),
        "mlp_down_w": w(ks[18], (D_FF, D_MODEL), D_FF),
        "norm_f_w": gain(ks[19], D_MODEL),
    }


def reference(x, mem, positions, norm_mix_w, w_in, conv_w, conv_b, conv_ln_w, conv_ln_b, ret_gn_w, w_out,
              norm_xattn_w, norm_mem_w, xq_w, xkv_w, xo_w, norm_mlp_w, mlp_up_w, mlp_down_w, norm_f_w):
    h = x
    mem_n = rmsnorm(mem, norm_mem_w)
    for _ in range(DEPTH):
        h = h + head_group_mixer(rmsnorm(h, norm_mix_w), positions, w_in, conv_w, conv_b,
                                 conv_ln_w, conv_ln_b, ret_gn_w, w_out)
        h = h + memory_cross_attention(rmsnorm(h, norm_xattn_w), mem_n, xq_w, xkv_w, xo_w)
        h = h + sq_relu_mlp(rmsnorm(h, norm_mlp_w), mlp_up_w, mlp_down_w)
    return rmsnorm(h, norm_f_w).astype(x.dtype)
```

```cpp
#include <hip/hip_runtime.h>
#include <cstdio>
#include <cstdint>
#include <cmath>

#ifndef MK_N_LAUNCHES
#define MK_N_LAUNCHES 1
#endif

namespace pg8 {
#define PG8_LAS __attribute__((address_space(3)))
typedef unsigned short bf16_t;
typedef short bf16x8 __attribute__((ext_vector_type(8)));
typedef float f32x4 __attribute__((ext_vector_type(4)));
typedef unsigned u32x4 __attribute__((ext_vector_type(4)));
constexpr int BM = 256, BK = 64, HALF = 128, HTB = HALF * BK * 2, STAGE_BYTES = 8 * HTB, NXCD = 8, WGM = 8;

__host__ __device__ __forceinline__ int lds_byte(int r, int c) { const int st = (r >> 4) * 2 + (c >> 5), rr = r & 15, cc = c & 31, ob = rr * 64 + cc * 2; return st * 1024 + (ob ^ (((ob >> 9) & 1) << 5)); }
__host__ __device__ __forceinline__ void stage_rc(int b, int& R, int& C) { const int st = b / 1024, sb = b % 1024, swz = sb ^ (((sb >> 9) & 1) << 5); R = (st >> 1) * 16 + swz / 64; C = (st & 1) * 32 + (swz % 64) / 2; }
__host__ __device__ __forceinline__ int perm32(int rho) { const int n = rho >> 4, i = rho & 15; return 8 * (i >> 2) + 4 * n + (i & 3); }

struct Unit { const char* a; const char* b; int pm, pn; };
struct Shape { int K, lda, ldb; };

__device__ __forceinline__ void tile_map(int L, int nM, int nN, int& pm, int& pn) {
    const int nwg = nM * nN; int wgid = L;
    { const int q = nwg / NXCD, r = nwg % NXCD, xcd = wgid % NXCD, off = wgid / NXCD; wgid = (xcd < r ? xcd * (q + 1) : r * (q + 1) + (xcd - r) * q) + off; }
    const int nig = WGM * nN, gid = wgid / nig, fm = gid * WGM, gsz = (nM - fm) < WGM ? (nM - fm) : WGM;
    pm = fm + ((wgid % nig) % gsz); pn = (wgid % nig) / gsz;
}

__device__ __forceinline__ unsigned cvt_pk_bf16(float lo, float hi) { unsigned r; asm volatile("v_cvt_pk_bf16_f32 %0, %1, %2" : "=v"(r) : "v"(lo), "v"(hi)); return r; }
__device__ __forceinline__ u32x4 pack8(const f32x4 v0, const f32x4 v1) { u32x4 w; w.x = cvt_pk_bf16(v0[0], v0[1]); w.y = cvt_pk_bf16(v0[2], v0[3]); w.z = cvt_pk_bf16(v1[0], v1[1]); w.w = cvt_pk_bf16(v1[2], v1[3]); return w; }

typedef f32x4 Acc[2][2][4][2];

template <class Epi, class Sched>
__device__ __forceinline__ void gemm_phase(PG8_LAS unsigned char* lds, const Shape g, const Sched& S, const Epi& E) {
    const int tid = threadIdx.x, wid = __builtin_amdgcn_readfirstlane(tid >> 6), lane = tid & 63, wr = wid >> 2, wc = wid & 3, fr = lane & 15, fq = lane >> 4;
    int K = g.K; asm volatile("" : "+s"(K)); const int nt = K / BK;
    unsigned voffA[2], voffB[2];
#pragma unroll
    for (int i = 0; i < 2; ++i) { int R, C; stage_rc(tid * 16 + i * 8192, R, C); const int Rb = (R & ~31) + perm32(R & 31);
        voffA[i] = (unsigned)(R * g.lda + C) * 2u; voffB[i] = (unsigned)(Rb * g.ldb + C) * 2u; }
    const size_t kstep = (size_t)(BK * 2);
    const size_t hstepA = (size_t)HALF * g.lda * 2, hstepB = (size_t)HALF * g.ldb * 2;
    const unsigned ldsw = (unsigned)wid * 1024u;
    const int aoff = lds_byte(wr * 64 + fr, fq * 8), boff = lds_byte(wc * 32 + fr, fq * 8);
#define PG8_SA(b, h) (((b) * 2 + (h)) * HTB)
#define PG8_SB(b, h) ((4 + (b) * 2 + (h)) * HTB)
#define PG8_STAGE(bufoff, gbase, voff) do { _Pragma("unroll") for (int _i = 0; _i < 2; ++_i) \
        __builtin_amdgcn_global_load_lds((const unsigned*)((const char*)(gbase) + (voff)[_i]), (PG8_LAS unsigned*)(lds + (bufoff) + ldsw + _i * 8192), 16, 0, 0); } while (0)
#define PG8_LDA(dst, b, h) do { _Pragma("unroll") for (int m = 0; m < 4; ++m) _Pragma("unroll") for (int k = 0; k < 2; ++k) dst[m][k] = *(const PG8_LAS bf16x8*)(lds + PG8_SA(b, h) + aoff + m * 2048 + k * 1024); } while (0)
#define PG8_LDB(dst, b, h) do { _Pragma("unroll") for (int n = 0; n < 2; ++n) _Pragma("unroll") for (int k = 0; k < 2; ++k) dst[n][k] = *(const PG8_LAS bf16x8*)(lds + PG8_SB(b, h) + boff + n * 2048 + k * 1024); } while (0)
#define PG8_MMA(ai, bj, At, Bt) do { __builtin_amdgcn_s_setprio(1); _Pragma("unroll") for (int m = 0; m < 4; ++m) _Pragma("unroll") for (int n = 0; n < 2; ++n) _Pragma("unroll") for (int k = 0; k < 2; ++k) \
        acc[ai][bj][m][n] = __builtin_amdgcn_mfma_f32_16x16x32_bf16(Bt[n][k], At[m][k], acc[ai][bj][m][n], 0, 0, 0); __builtin_amdgcn_s_setprio(0); } while (0)
#define PG8_WAIT_V(n) asm volatile("s_waitcnt vmcnt(" #n ")" ::: "memory")
#define PG8_WAIT_L(n) asm volatile("s_waitcnt lgkmcnt(" #n ")" ::: "memory")
#define PG8_BAR __builtin_amdgcn_s_barrier()
#define PG8_SCHED __builtin_amdgcn_sched_barrier(0)
    Unit cur, nxt; int ui = 0;
    if (!S.next(0, cur)) return;
    Acc acc;
#pragma unroll
    for (int a = 0; a < 2; ++a)
#pragma unroll
        for (int b = 0; b < 2; ++b)
#pragma unroll
            for (int m = 0; m < 4; ++m)
#pragma unroll
                for (int n = 0; n < 2; ++n) acc[a][b][m][n] = (f32x4){0.f, 0.f, 0.f, 0.f};
    bf16x8 At[4][2], B0[2][2], B1[2][2];
    const char* cA = cur.a; const char* cB = cur.b;
    PG8_STAGE(PG8_SB(0, 0), cB, voffB); PG8_STAGE(PG8_SB(0, 1), cB + hstepB, voffB); PG8_STAGE(PG8_SA(0, 0), cA, voffA); PG8_STAGE(PG8_SA(0, 1), cA + hstepA, voffA);
    if (wr == 1) PG8_BAR;
    PG8_WAIT_V(2); PG8_BAR;
    PG8_STAGE(PG8_SB(1, 0), cB + kstep, voffB); PG8_STAGE(PG8_SA(1, 0), cA + kstep, voffA); PG8_STAGE(PG8_SB(1, 1), cB + hstepB + kstep, voffB);
    PG8_WAIT_V(6); PG8_BAR;
    for (;;) {
        const bool has_next = S.next(ui + 1, nxt);
        const char* nA = has_next ? nxt.a : cA; const char* nB = has_next ? nxt.b : cB;
        for (int t = 0; t < nt; t += 2) {
            const bool last = (t == nt - 2);
            const char* a1 = cA + (size_t)(t + 1) * kstep;
            const char* a2 = last ? nA : cA + (size_t)(t + 2) * kstep; const char* b2 = last ? nB : cB + (size_t)(t + 2) * kstep;
            const char* a3 = a2 + kstep; const char* b3 = b2 + kstep;
            PG8_LDB(B0, 0, 0); PG8_LDB(B1, 0, 1); PG8_SCHED; PG8_LDA(At, 0, 0); PG8_STAGE(PG8_SA(1, 1), a1 + hstepA, voffA);
            PG8_WAIT_V(8); PG8_WAIT_L(0); PG8_BAR; PG8_MMA(0, 0, At, B0); PG8_MMA(0, 1, At, B1); PG8_BAR; PG8_SCHED;
            PG8_LDA(At, 0, 1); PG8_STAGE(PG8_SB(0, 0), b2, voffB); PG8_STAGE(PG8_SB(0, 1), b2 + hstepB, voffB); PG8_STAGE(PG8_SA(0, 0), a2, voffA);
            PG8_WAIT_V(8); PG8_WAIT_L(0); PG8_BAR; PG8_MMA(1, 0, At, B0); PG8_MMA(1, 1, At, B1); PG8_BAR; PG8_SCHED;
            PG8_LDB(B0, 1, 0); PG8_LDB(B1, 1, 1); PG8_SCHED; PG8_LDA(At, 1, 0); PG8_STAGE(PG8_SA(0, 1), a2 + hstepA, voffA);
            PG8_WAIT_V(8); PG8_WAIT_L(0); PG8_BAR; PG8_MMA(0, 0, At, B0); PG8_MMA(0, 1, At, B1); PG8_BAR; PG8_SCHED;
            PG8_LDA(At, 1, 1); PG8_STAGE(PG8_SB(1, 0), b3, voffB); PG8_STAGE(PG8_SB(1, 1), b3 + hstepB, voffB); PG8_STAGE(PG8_SA(1, 0), a3, voffA);
            PG8_WAIT_V(8); PG8_WAIT_L(0); PG8_BAR; PG8_MMA(1, 0, At, B0); PG8_MMA(1, 1, At, B1); PG8_BAR; PG8_SCHED;
        }
        if (wr == 0) PG8_BAR;
        E(acc, cur, wr, wc, fr, fq, lds);
        if (!has_next) break;
#pragma unroll
        for (int a = 0; a < 2; ++a)
#pragma unroll
            for (int b = 0; b < 2; ++b)
#pragma unroll
                for (int m = 0; m < 4; ++m)
#pragma unroll
                    for (int n = 0; n < 2; ++n) acc[a][b][m][n] = (f32x4){0.f, 0.f, 0.f, 0.f};
        cur = nxt; cA = nA; cB = nB; ++ui;
        if (wr == 1) PG8_BAR;
    }
    PG8_WAIT_V(0);
    PG8_BAR;
#undef PG8_SA
#undef PG8_SB
#undef PG8_STAGE
#undef PG8_LDA
#undef PG8_LDB
#undef PG8_MMA
#undef PG8_WAIT_V
#undef PG8_WAIT_L
#undef PG8_BAR
#undef PG8_SCHED
}
}

constexpr int NWAVES = 8;
constexpr int N_LAUNCHES = MK_N_LAUNCHES;
constexpr int N_PHASES = 13;
constexpr int BATCH = 2, SEQ = 8192, D = 1024, M = BATCH * SEQ, DIN = 2560, FF = 4096, NMEM = 256, MROWS = BATCH * NMEM;
constexpr int CCH = 512, CONVW = 31, RH = 8, DK = 32, DV = 64, CHUNK = 64, NCH = SEQ / CHUNK, NCHUNKS = M / CHUNK;
constexpr float EPS = 1e-6f;
constexpr float LOG2E = 1.4426950408889634f;

constexpr size_t MiB = 1u << 20;
constexpr size_t WS_CTL = 0, CTL_ZERO_BYTES = 1 * MiB;
constexpr size_t CTL_RSS1 = 256 * 1024, CTL_RSS2 = 320 * 1024;
constexpr size_t WS_COS = 2 * MiB, WS_SIN = 3 * MiB;
constexpr size_t WS_RS0 = 4 * MiB;
constexpr size_t WS_KMEM = 5 * MiB, WS_VT = 6 * MiB;
constexpr size_t WS_WOUT = 8 * MiB, WS_WQ = 10 * MiB, WS_WO = 12 * MiB, WS_WUP = 14 * MiB, WS_WDN = 22 * MiB;
constexpr size_t WS_E = 40 * MiB;
constexpr size_t WS_XB = WS_E, WS_MEMN = WS_E + 32 * MiB, WS_WIN = WS_E + 33 * MiB, WS_WKV = WS_E + 38 * MiB;
constexpr size_t WS_RA = 40 * MiB;
constexpr size_t WS_RB = 82 * MiB;
constexpr size_t WS_U = WS_RB, WS_QK = WS_RB + 16 * MiB, WS_V = WS_RB + 32 * MiB, WS_SG = WS_RB + 48 * MiB;
constexpr size_t WS_HB = WS_RB;
constexpr size_t WS_P = WS_RB + 32 * MiB;
constexpr size_t WS_KVT = 146 * MiB;
constexpr size_t WS_ST = 162 * MiB;
constexpr size_t WS_HID = 128 * MiB;
constexpr size_t WS_END = 256 * MiB;
constexpr int CW_TMO = 0, CW_CODE = 1, CW_BAR = 4096;

constexpr int RING_OFF = 0, RING_BYTES = 131072;
constexpr int LDSCTL_OFF = RING_BYTES, MISC_OFF = LDSCTL_OFF + 320;
constexpr int XS_OFF = RING_BYTES + 1024;
constexpr int LDS_BYTES = 147456;

#define GAS __attribute__((address_space(1)))
#define LAS __attribute__((address_space(3)))
typedef unsigned short bf16;
typedef unsigned v4u __attribute__((ext_vector_type(4)));
typedef float f32x4 __attribute__((ext_vector_type(4)));
typedef float f32x2 __attribute__((ext_vector_type(2)));
typedef GAS unsigned gu32;
#define RLX_AGENT __ATOMIC_RELAXED, __HIP_MEMORY_SCOPE_AGENT
#define LDS_WAIT() asm volatile("s_waitcnt lgkmcnt(0)" ::: "memory")
#define VM_WAIT() asm volatile("s_waitcnt vmcnt(0)" ::: "memory")
__device__ __forceinline__ unsigned f2bf(float f) { unsigned u = __builtin_bit_cast(unsigned, f); return (u + 0x7fffu + ((u >> 16) & 1u)) >> 16; }
__device__ __forceinline__ unsigned pk2(float lo, float hi) { return f2bf(lo) | (f2bf(hi) << 16); }
__device__ __forceinline__ float bflo(unsigned w) { return __uint_as_float(w << 16); }
__device__ __forceinline__ float bfhi(unsigned w) { return __uint_as_float(w & 0xffff0000u); }
__device__ __forceinline__ float bf1(bf16 b) { return __uint_as_float((unsigned)b << 16); }
__device__ __forceinline__ float fast_sigmoid(float x) { return __builtin_amdgcn_rcpf(1.0f + __builtin_amdgcn_exp2f(-x * LOG2E)); }
__device__ __forceinline__ float wave_sum(float v) {
#pragma unroll
    for (int o = 1; o < 64; o <<= 1) v += __shfl_xor(v, o);
    return v;
}

#define XB_TMO      128
#define XB_XCNT(j)  (256  + 64 * (j))
#define XB_XSUB(j)  (1280 + 64 * (j))
#define XB_XGEN(j)  (2304 + 64 * (j))
#define XB_TOP      3328
#define XB_TOPGEN   3392
#define XCD_BAR_WORDS 3456
#define XB_SPIN_CAP (1u << 18)
__device__ __forceinline__ unsigned xb_ld(unsigned* p)              { return __hip_atomic_load(p, __ATOMIC_RELAXED, __HIP_MEMORY_SCOPE_AGENT); }
__device__ __forceinline__ unsigned xb_add(unsigned* p, unsigned v) { return __hip_atomic_fetch_add(p, v, __ATOMIC_RELAXED, __HIP_MEMORY_SCOPE_AGENT); }
__device__ __forceinline__ unsigned xb_xcc_id() { return (unsigned)__builtin_amdgcn_s_getreg((3 << 11) | 20) & 0xFu; }
#define XB_SPIN(cond, bar) do { unsigned _sp = 0; while (cond) { __builtin_amdgcn_s_sleep(1); \
    if ((++_sp & 255u) == 0u) { if (xb_ld(&(bar)[XB_TMO])) break; if (_sp > XB_SPIN_CAP) { atomicAdd(&(bar)[XB_TMO], 1u); break; } } } } while (0)
struct XcdBarrier { unsigned* bar; unsigned x; volatile LAS unsigned* st; };
__device__ __forceinline__ XcdBarrier xcd_barrier_post(unsigned* bar, volatile LAS unsigned* st) {
    XcdBarrier b; b.bar = bar; b.x = xb_xcc_id(); b.st = st;
    if (threadIdx.x == 0) (void)xb_add(&bar[XB_XCNT(b.x)], 1u);
    return b;
}
__device__ __forceinline__ void xcd_barrier_complete(unsigned* bar, unsigned x, unsigned& nloc, unsigned& nx) {
    const unsigned G = gridDim.x * gridDim.y * gridDim.z;
    unsigned sum, cnt, mine, sp = 0u;
    for (;;) {
        sum = 0u; cnt = 0u; mine = 0u;
#pragma unroll
        for (unsigned j = 0; j < 16; ++j) { const unsigned c = xb_ld(&bar[XB_XCNT(j)]); sum += c; cnt += (c > 0u) ? 1u : 0u; mine = (j == x) ? c : mine; }
        if (sum == G) break;
        __builtin_amdgcn_s_sleep(1);
        if ((++sp & 255u) == 0u) { if (xb_ld(&bar[XB_TMO])) break; if (sp > XB_SPIN_CAP) { atomicAdd(&bar[XB_TMO], 1u); break; } }
    }
    nloc = mine > 0u ? mine : 1u; nx = cnt > 0u ? cnt : 1u;
}
__device__ __forceinline__ void xcd_barrier(const XcdBarrier& b) {
    asm volatile("s_waitcnt vmcnt(0)" ::: "memory");
    __syncthreads();
    if (threadIdx.x == 0) {
        unsigned* bar = b.bar;
        __builtin_amdgcn_s_waitcnt(0);
        unsigned nloc = b.st[0], nx = b.st[1];
        if (nloc == 0u) { xcd_barrier_complete(bar, b.x, nloc, nx); b.st[0] = nloc; b.st[1] = nx; }
        const unsigned old = xb_add(&bar[XB_XSUB(b.x)], 1u);
        const unsigned gen = old / nloc;
        if (old + 1u == (gen + 1u) * nloc) {
            __builtin_amdgcn_fence(__ATOMIC_RELEASE, "agent");
            asm volatile("s_waitcnt vmcnt(0)" ::: "memory");
            const unsigned og = xb_add(&bar[XB_TOP], 1u);
            const unsigned tg = og / nx;
            if (og + 1u == (tg + 1u) * nx) xb_add(&bar[XB_TOPGEN], 1u);
            else XB_SPIN(xb_ld(&bar[XB_TOPGEN]) == tg, bar);
            __builtin_amdgcn_fence(__ATOMIC_ACQUIRE, "agent");
            xb_add(&bar[XB_XGEN(b.x)], 1u);
            asm volatile("s_waitcnt vmcnt(0)" ::: "memory");
        } else {
            XB_SPIN(xb_ld(&bar[XB_XGEN(b.x)]) == gen, bar);
            __builtin_amdgcn_fence(__ATOMIC_ACQUIRE, "agent");
            asm volatile("s_waitcnt vmcnt(0)" ::: "memory");
        }
    }
    __syncthreads();
}

struct Args { const float* in[20]; float* out; unsigned char* ws; float inv_freq[16]; float gl2[8]; float g64[8]; int ph_lo, ph_hi, li, pad; };
struct Frame {
    LAS unsigned char* lds;
    int tid, lane, wave, vcu, G;
};

using pg8::Acc; using pg8::Unit; using pg8::pack8;
struct EpiIn {
    bf16 *U, *QK, *V, *SG, *KM, *VT; const float* rs0; const float* cosT; const float* sinT;
    __device__ __forceinline__ void operator()(Acc& acc, const Unit& u, int wr, int wc, int fr, int fq, LAS unsigned char*) const {
        const int t = u.pn, cl = wc * 32 + 8 * fq;
        if (t < 4) {
#pragma unroll
            for (int ai = 0; ai < 2; ++ai)
#pragma unroll
                for (int m = 0; m < 4; ++m) { const int row = u.pm * 256 + ai * 128 + wr * 64 + m * 16 + fr; const float rs = rs0[row];
                    f32x4 o0, o1;
#pragma unroll
                    for (int j = 0; j < 4; ++j) { o0[j] = acc[ai][0][m][0][j] * rs * fast_sigmoid(acc[ai][1][m][0][j] * rs); o1[j] = acc[ai][0][m][1][j] * rs * fast_sigmoid(acc[ai][1][m][1][j] * rs); }
                    *(v4u*)(U + (size_t)row * 512 + t * 128 + cl) = pack8(o0, o1); }
        } else if (t < 6) {
            const float sc = (t == 4) ? 0.17677669529663687f : 1.0f;
#pragma unroll
            for (int ai = 0; ai < 2; ++ai)
#pragma unroll
                for (int m = 0; m < 4; ++m) { const int row = u.pm * 256 + ai * 128 + wr * 64 + m * 16 + fr; const float rs = rs0[row] * sc;
                    const f32x4 c4 = *(const f32x4*)(cosT + (size_t)row * 16 + 4 * fq), s4 = *(const f32x4*)(sinT + (size_t)row * 16 + 4 * fq);
#pragma unroll
                    for (int bj = 0; bj < 2; ++bj) { const f32x4 t1 = acc[ai][bj][m][0] * rs, t2 = acc[ai][bj][m][1] * rs;
                        const f32x4 o1 = t1 * c4 - t2 * s4, o2 = t1 * s4 + t2 * c4;
                        *(v4u*)(QK + (size_t)row * 512 + (t - 4) * 256 + bj * 128 + cl) = pack8(o1, o2); } }
        } else if (t < 10) {
            bf16* O = (t < 8) ? V : SG; const int c0 = ((t - 6) & 1) * 256; const bool act = (t >= 8);
#pragma unroll
            for (int ai = 0; ai < 2; ++ai)
#pragma unroll
                for (int m = 0; m < 4; ++m) { const int row = u.pm * 256 + ai * 128 + wr * 64 + m * 16 + fr; const float rs = rs0[row];
#pragma unroll
                    for (int bj = 0; bj < 2; ++bj) { f32x4 v0 = acc[ai][bj][m][0] * rs, v1 = acc[ai][bj][m][1] * rs;
                        if (act) {
#pragma unroll
                            for (int j = 0; j < 4; ++j) { v0[j] = v0[j] * fast_sigmoid(v0[j]); v1[j] = v1[j] * fast_sigmoid(v1[j]); } }
                        *(v4u*)(O + (size_t)row * 512 + c0 + bj * 128 + cl) = pack8(v0, v1); } }
        } else {
            bf16* O = (t < 14) ? KM : VT; const int ldc = (t < 14) ? 1024 : 512; const int c0 = ((t < 14) ? (t - 10) : (t - 14)) * 256;
#pragma unroll
            for (int ai = 0; ai < 2; ++ai)
#pragma unroll
                for (int m = 0; m < 4; ++m) { const int row = u.pm * 256 + ai * 128 + wr * 64 + m * 16 + fr;
#pragma unroll
                    for (int bj = 0; bj < 2; ++bj) *(v4u*)(O + (size_t)row * ldc + c0 + bj * 128 + cl) = pack8(acc[ai][bj][m][0], acc[ai][bj][m][1]); }
        }
    }
};
struct EpiRes {
    const float* base; float* out; bf16* outb; float* rss;
    __device__ __forceinline__ void operator()(Acc& acc, const Unit& u, int wr, int wc, int fr, int fq, LAS unsigned char*) const {
        const int cl = u.pn * 256 + wc * 32 + 8 * fq;
#pragma unroll
        for (int ai = 0; ai < 2; ++ai)
#pragma unroll
            for (int m = 0; m < 4; ++m) { const int row = u.pm * 256 + ai * 128 + wr * 64 + m * 16 + fr; float ss = 0.f;
#pragma unroll
                for (int bj = 0; bj < 2; ++bj) { const size_t off = (size_t)row * D + cl + bj * 128;
                    const f32x4 v0 = acc[ai][bj][m][0] + *(const f32x4*)(base + off), v1 = acc[ai][bj][m][1] + *(const f32x4*)(base + off + 4);
                    *(f32x4*)(out + off) = v0; *(f32x4*)(out + off + 4) = v1;
                    if (outb) *(v4u*)(outb + off) = pack8(v0, v1);
                    ss += (v0[0] * v0[0] + v0[1] * v0[1]) + (v0[2] * v0[2] + v0[3] * v0[3]) + (v1[0] * v1[0] + v1[1] * v1[1]) + (v1[2] * v1[2] + v1[3] * v1[3]); }
                if (rss) { ss += __shfl_xor(ss, 16); ss += __shfl_xor(ss, 32); if (fq == 0) atomicAdd(rss + row, ss); } }
    }
};
template <int ACT> struct EpiScale {
    bf16* O; int ldc; const float* rss;
    __device__ __forceinline__ void operator()(Acc& acc, const Unit& u, int wr, int wc, int fr, int fq, LAS unsigned char*) const {
        const int cl = u.pn * 256 + wc * 32 + 8 * fq;
#pragma unroll
        for (int ai = 0; ai < 2; ++ai)
#pragma unroll
            for (int m = 0; m < 4; ++m) { const int row = u.pm * 256 + ai * 128 + wr * 64 + m * 16 + fr; const float rs = 1.0f / sqrtf(rss[row] * (1.0f / D) + EPS);
#pragma unroll
                for (int bj = 0; bj < 2; ++bj) { f32x4 v0 = acc[ai][bj][m][0] * rs, v1 = acc[ai][bj][m][1] * rs;
                    if (ACT == 1) {
#pragma unroll
                        for (int j = 0; j < 4; ++j) { const float a = fmaxf(v0[j], 0.f), b = fmaxf(v1[j], 0.f); v0[j] = a * a; v1[j] = b * b; } }
                    *(v4u*)(O + (size_t)row * ldc + cl + bj * 128) = pack8(v0, v1); } }
    }
};
struct EpiPlain {
    bf16* O; int ldc;
    __device__ __forceinline__ void operator()(Acc& acc, const Unit& u, int wr, int wc, int fr, int fq, LAS unsigned char*) const {
        const int cl = u.pn * 256 + wc * 32 + 8 * fq;
#pragma unroll
        for (int ai = 0; ai < 2; ++ai)
#pragma unroll
            for (int m = 0; m < 4; ++m) { const int row = u.pm * 256 + ai * 128 + wr * 64 + m * 16 + fr;
#pragma unroll
                for (int bj = 0; bj < 2; ++bj) *(v4u*)(O + (size_t)row * ldc + cl + bj * 128) = pack8(acc[ai][bj][m][0], acc[ai][bj][m][1]); }
    }
};
struct EpiSoftmax {
    bf16* O;
    __device__ __forceinline__ void operator()(Acc& acc, const Unit& u, int wr, int wc, int fr, int fq, LAS unsigned char* lds) const {
        LAS f32x2* X = (LAS f32x2*)(lds + XS_OFF);
        const float sc = 0.0625f * LOG2E;
#pragma unroll
        for (int ai = 0; ai < 2; ++ai)
#pragma unroll
            for (int m = 0; m < 4; ++m) { float mx = -3.0e38f;
#pragma unroll
                for (int bj = 0; bj < 2; ++bj)
#pragma unroll
                    for (int n = 0; n < 2; ++n)
#pragma unroll
                        for (int j = 0; j < 4; ++j) mx = fmaxf(mx, acc[ai][bj][m][n][j]);
                mx = fmaxf(mx, __shfl_xor(mx, 16)); mx = fmaxf(mx, __shfl_xor(mx, 32));
                float s = 0.f;
#pragma unroll
                for (int bj = 0; bj < 2; ++bj)
#pragma unroll
                    for (int n = 0; n < 2; ++n)
#pragma unroll
                        for (int j = 0; j < 4; ++j) { const float e = __builtin_amdgcn_exp2f((acc[ai][bj][m][n][j] - mx) * sc); acc[ai][bj][m][n][j] = e; s += e; }
                s += __shfl_xor(s, 16); s += __shfl_xor(s, 32);
                if (fq == 0) X[(ai * 128 + wr * 64 + m * 16 + fr) * 4 + wc] = (f32x2){mx, s};
                asm volatile("" ::: "memory"); }
        LDS_WAIT(); __builtin_amdgcn_s_barrier(); asm volatile("" ::: "memory");
        const int cl = u.pn * 256 + wc * 32 + 8 * fq;
#pragma unroll
        for (int ai = 0; ai < 2; ++ai)
#pragma unroll
            for (int m = 0; m < 4; ++m) { const int rl = ai * 128 + wr * 64 + m * 16 + fr; const int row = u.pm * 256 + rl;
                const f32x2 x0 = X[rl * 4 + 0], x1 = X[rl * 4 + 1], x2 = X[rl * 4 + 2], x3 = X[rl * 4 + 3];
                const float mt = fmaxf(fmaxf(x0.x, x1.x), fmaxf(x2.x, x3.x));
                const float L = x0.y * __builtin_amdgcn_exp2f((x0.x - mt) * sc) + x1.y * __builtin_amdgcn_exp2f((x1.x - mt) * sc) + x2.y * __builtin_amdgcn_exp2f((x2.x - mt) * sc) + x3.y * __builtin_amdgcn_exp2f((x3.x - mt) * sc);
                const float mo = (wc == 0) ? x0.x : (wc == 1) ? x1.x : (wc == 2) ? x2.x : x3.x;
                const float f = __builtin_amdgcn_exp2f((mo - mt) * sc) / L;
#pragma unroll
                for (int bj = 0; bj < 2; ++bj) *(v4u*)(O + (size_t)row * D + cl + bj * 128) = pack8(acc[ai][bj][m][0] * f, acc[ai][bj][m][1] * f);
                asm volatile("" ::: "memory"); }
        LDS_WAIT(); __builtin_amdgcn_s_barrier(); asm volatile("" ::: "memory");
    }
};

constexpr size_t TS = (size_t)256 * 1024 * 2;
struct SchedPlain {
    const char* A; const char* Bt; size_t ta, tb; int nM, nN, G, c;
    __device__ __forceinline__ bool next(int i, Unit& u) const {
        const long L = (long)i * G + c; if (L >= (long)nM * nN) return false;
        int pm, pn; pg8::tile_map((int)L, nM, nN, pm, pn); u.pm = pm; u.pn = pn; u.a = A + (size_t)pm * ta; u.b = Bt + (size_t)pn * tb; return true;
    }
};
struct SchedIn {
    const char* E; int G, c;
    __device__ __forceinline__ bool next(int i, Unit& u) const {
        const long L = (long)i * G + c;
        if (L < 640) { int pm, pn; pg8::tile_map((int)L, 64, 10, pm, pn); u.pm = pm; u.pn = pn; u.a = E + (size_t)pm * TS; u.b = E + (size_t)(66 + pn) * TS; return true; }
        if (L < 648) { const int x = (int)L - 640, pm = x >> 2, pn = x & 3; u.pm = pm; u.pn = 10 + pn; u.a = E + (size_t)(64 + pm) * TS; u.b = E + (size_t)(76 + pn) * TS; return true; }
        if (L < 656) { const int x = (int)L - 648, pm = x >> 1, pn = x & 1; u.pm = pm; u.pn = 14 + pn; u.a = E + (size_t)(80 + pm) * TS; u.b = E + (size_t)(64 + pn) * TS; return true; }
        return false;
    }
};
struct SchedAttn {
    const char* A; const char* B; size_t b_batch, b_head; int G, c;
    __device__ __forceinline__ bool next(int i, Unit& u) const {
        const long L = (long)i * G + c; if (L >= 256) return false;
        int pm, pn; pg8::tile_map((int)L, 64, 4, pm, pn); u.pm = pm; u.pn = pn;
        u.a = A + (size_t)pm * TS + (size_t)pn * 512; u.b = B + (size_t)(pm >> 5) * b_batch + (size_t)pn * b_head; return true;
    }
};

__device__ __forceinline__ void p0_transpose_item(const float* W, int K, int N, int k0, int s0, bf16* WT, int dst0, bool perm, const float* kscale, LAS float* scr, int lane) {
#pragma unroll 8
    for (int i = 0; i < 32; ++i) { const int kk = 2 * i + (lane >> 5); float v = W[(size_t)(k0 + kk) * N + s0 + (lane & 31)]; if (kscale) v *= kscale[k0 + kk]; scr[kk * 33 + (lane & 31)] = v; }
    LDS_WAIT(); asm volatile("" ::: "memory");
    const int c = lane & 7;
#pragma unroll
    for (int j = 0; j < 4; ++j) { const int n = (lane >> 3) + 8 * j; const LAS float* s = scr + (8 * c) * 33 + n;
        v4u o; o.x = pk2(s[0 * 33], s[1 * 33]); o.y = pk2(s[2 * 33], s[3 * 33]); o.z = pk2(s[4 * 33], s[5 * 33]); o.w = pk2(s[6 * 33], s[7 * 33]);
        const int dn = perm ? pg8::perm32(n) : n;
        *(GAS v4u*)(WT + (size_t)(dst0 + dn) * K + k0 + 8 * c) = o; }
    LDS_WAIT(); asm volatile("" ::: "memory");
}
__device__ __forceinline__ void p0_prologue(Frame& F, const Args& a) {
    unsigned char* ws = a.ws;
    LAS float* scr = (LAS float*)(F.lds + RING_OFF + F.wave * 16384);
    const int gw = F.vcu * NWAVES + F.wave, NGW = F.G * NWAVES;
    constexpr int I_IN = 16 * 80, I_SQ = 16 * 32, I_KV = 16 * 64, I_UP = 16 * 128, I_DN = 64 * 32;
    constexpr int NITEMS = I_IN + 3 * I_SQ + I_KV + I_UP + I_DN;
    for (int it = gw; it < NITEMS; it += NGW) {
        int r = it;
        if (r < I_IN) { const int kb = r / 80, nb = r % 80, s0 = 32 * nb; int dst; bool perm = false;
            if (s0 < 512) dst = 256 * (s0 >> 7) + (s0 & 127);
            else if (s0 < 1024) { const int c = s0 - 512; dst = 256 * (c >> 7) + 128 + (c & 127); }
            else { dst = s0; perm = (s0 < 1536); }
            p0_transpose_item(a.in[4], D, DIN, 64 * kb, s0, (bf16*)(ws + WS_WIN), dst, perm, a.in[3], scr, F.lane); continue; } r -= I_IN;
        if (r < I_SQ) { p0_transpose_item(a.in[10], D, D, 64 * (r / 32), 32 * (r % 32), (bf16*)(ws + WS_WOUT), 32 * (r % 32), false, nullptr, scr, F.lane); continue; } r -= I_SQ;
        if (r < I_SQ) { p0_transpose_item(a.in[13], D, D, 64 * (r / 32), 32 * (r % 32), (bf16*)(ws + WS_WQ), 32 * (r % 32), false, a.in[11], scr, F.lane); continue; } r -= I_SQ;
        if (r < I_SQ) { p0_transpose_item(a.in[15], D, D, 64 * (r / 32), 32 * (r % 32), (bf16*)(ws + WS_WO), 32 * (r % 32), false, nullptr, scr, F.lane); continue; } r -= I_SQ;
        if (r < I_KV) { p0_transpose_item(a.in[14], D, 2 * D, 64 * (r / 64), 32 * (r % 64), (bf16*)(ws + WS_WKV), 32 * (r % 64), false, nullptr, scr, F.lane); continue; } r -= I_KV;
        if (r < I_UP) { p0_transpose_item(a.in[17], D, FF, 64 * (r / 128), 32 * (r % 128), (bf16*)(ws + WS_WUP), 32 * (r % 128), false, a.in[16], scr, F.lane); continue; } r -= I_UP;
        p0_transpose_item(a.in[18], FF, D, 64 * (r / 32), 32 * (r % 32), (bf16*)(ws + WS_WDN), 32 * (r % 32), false, nullptr, scr, F.lane);
    }
    for (int m = gw; m < M + MROWS; m += NGW) {
        const bool ismem = (m >= M);
        const float* src = ismem ? a.in[1] + (size_t)(m - M) * D : a.in[0] + (size_t)m * D;
        const GAS f32x4* xr = (const GAS f32x4*)src + F.lane;
        f32x4 v[4]; float s = 0.f;
#pragma unroll
        for (int j = 0; j < 4; ++j) { v[j] = xr[64 * j]; s += (v[j].x * v[j].x + v[j].y * v[j].y) + (v[j].z * v[j].z + v[j].w * v[j].w); }
        const float rstd = 1.0f / sqrtf(wave_sum(s) * (1.0f / D) + EPS);
        bf16* dst = ismem ? (bf16*)(ws + WS_MEMN) + (size_t)(m - M) * D : (bf16*)(ws + WS_XB) + (size_t)m * D;
        GAS unsigned long long* o8 = (GAS unsigned long long*)dst + F.lane;
        if (ismem) {
            const GAS f32x4* wr = (const GAS f32x4*)a.in[12] + F.lane;
#pragma unroll
            for (int j = 0; j < 4; ++j) { const f32x4 w = wr[64 * j]; v[j] = v[j] * rstd * w; }
        } else if (F.lane == 0) ((float*)(ws + WS_RS0))[m] = rstd;
#pragma unroll
        for (int j = 0; j < 4; ++j) o8[64 * j] = (unsigned long long)pk2(v[j].x, v[j].y) | ((unsigned long long)pk2(v[j].z, v[j].w) << 32);
    }
    {
        const int* pos = (const int*)a.in[2]; float* ct = (float*)(ws + WS_COS); float* st = (float*)(ws + WS_SIN);
        for (int idx = F.vcu * 512 + F.tid; idx < M * 16; idx += F.G * 512) {
            const int row = idx >> 4, i = idx & 15;
            const float ang = (float)pos[row] * a.inv_freq[i];
            double rev = (double)ang * 0.15915494309189535; rev -= __builtin_rint(rev);
            const float rf = (float)rev;
            ct[idx] = __builtin_amdgcn_cosf(rf); st[idx] = __builtin_amdgcn_sinf(rf);
        }
    }
}

__device__ __forceinline__ void p2_kv(Frame& F, const Args& a) {
    const bf16* QK = (const bf16*)(a.ws + WS_QK); const bf16* V = (const bf16*)(a.ws + WS_V); float* KVT = (float*)(a.ws + WS_KVT);
    const int h = F.wave, e = F.lane; const float gl2 = a.gl2[h];
    for (int gc = F.vcu; gc < NCHUNKS; gc += F.G) {
        float acc[32];
#pragma unroll
        for (int d = 0; d < 32; ++d) acc[d] = 0.f;
        const size_t row0 = (size_t)gc * 64;
#pragma unroll 2
        for (int j = 0; j < 64; ++j) {
            const float vz = bf1(V[(row0 + j) * 512 + h * 64 + e]) * __builtin_amdgcn_exp2f(gl2 * (float)(63 - j));
            const GAS v4u* kp = (const GAS v4u*)(QK + (row0 + j) * 512 + 256 + h * 32);
#pragma unroll
            for (int q = 0; q < 4; ++q) { const v4u kk = kp[q];
                acc[q * 8 + 0] += vz * bflo(kk.x); acc[q * 8 + 1] += vz * bfhi(kk.x); acc[q * 8 + 2] += vz * bflo(kk.y); acc[q * 8 + 3] += vz * bfhi(kk.y);
                acc[q * 8 + 4] += vz * bflo(kk.z); acc[q * 8 + 5] += vz * bfhi(kk.z); acc[q * 8 + 6] += vz * bflo(kk.w); acc[q * 8 + 7] += vz * bfhi(kk.w); }
        }
        GAS f32x4* o = (GAS f32x4*)(KVT + (((size_t)gc * 8 + h) * 64 + e) * 32);
#pragma unroll
        for (int q = 0; q < 8; ++q) o[q] = (f32x4){acc[4 * q], acc[4 * q + 1], acc[4 * q + 2], acc[4 * q + 3]};
    }
}
__device__ __forceinline__ void p3_scan(Frame& F, const Args& a) {
    const float* KVT = (const float*)(a.ws + WS_KVT); bf16* ST = (bf16*)(a.ws + WS_ST);
    for (int x = F.vcu * 512 + F.tid; x < BATCH * 16384; x += F.G * 512) {
        const int b = x >> 14, rem = x & 16383, h = rem >> 11; const float g = a.g64[h];
        float S = 0.f;
#pragma unroll 8
        for (int n = 0; n < NCH; ++n) { const size_t idx = ((size_t)(b * NCH + n)) * 16384 + rem; ST[idx] = (bf16)f2bf(S); S = g * S + KVT[idx]; }
    }
}
__device__ __forceinline__ void p4_ret(Frame& F, const Args& a, int gc) {
    const bf16* QK = (const bf16*)(a.ws + WS_QK); const bf16* V = (const bf16*)(a.ws + WS_V); const bf16* SG = (const bf16*)(a.ws + WS_SG);
    const bf16* ST = (const bf16*)(a.ws + WS_ST); bf16* MG = (bf16*)(a.ws + WS_RA);
    const int h = F.wave, i = F.lane; const float gl2 = a.gl2[h];
    const size_t row0 = (size_t)gc * 64, row = row0 + i;
    LAS float* SL = (LAS float*)(F.lds + RING_OFF + h * 16384);
    float q[32];
    { const GAS v4u* qp = (const GAS v4u*)(QK + row * 512 + h * 32);
#pragma unroll
      for (int t = 0; t < 4; ++t) { const v4u w = qp[t]; q[t * 8 + 0] = bflo(w.x); q[t * 8 + 1] = bfhi(w.x); q[t * 8 + 2] = bflo(w.y); q[t * 8 + 3] = bfhi(w.y); q[t * 8 + 4] = bflo(w.z); q[t * 8 + 5] = bfhi(w.z); q[t * 8 + 6] = bflo(w.w); q[t * 8 + 7] = bfhi(w.w); } }
#pragma unroll 1
    for (int j = 0; j < 64; ++j) {
        const GAS v4u* kp = (const GAS v4u*)(QK + (row0 + j) * 512 + 256 + h * 32);
        float s = 0.f;
#pragma unroll
        for (int t = 0; t < 4; ++t) { const v4u w = kp[t];
            s += q[t * 8 + 0] * bflo(w.x) + q[t * 8 + 1] * bfhi(w.x) + q[t * 8 + 2] * bflo(w.y) + q[t * 8 + 3] * bfhi(w.y) + q[t * 8 + 4] * bflo(w.z) + q[t * 8 + 5] * bfhi(w.z) + q[t * 8 + 6] * bflo(w.w) + q[t * 8 + 7] * bfhi(w.w); }
        SL[j * 64 + i] = s * __builtin_amdgcn_exp2f(gl2 * fabsf((float)(i - j)));
    }
    LDS_WAIT(); asm volatile("" ::: "memory");
    float y[64];
#pragma unroll
    for (int e = 0; e < 64; ++e) y[e] = 0.f;
#pragma unroll 1
    for (int j = 0; j < 64; ++j) {
        const float s = SL[j * 64 + i];
        const GAS v4u* vp = (const GAS v4u*)(V + (row0 + j) * 512 + h * 64);
#pragma unroll
        for (int t = 0; t < 8; ++t) { const v4u w = vp[t];
            y[t * 8 + 0] += s * bflo(w.x); y[t * 8 + 1] += s * bfhi(w.x); y[t * 8 + 2] += s * bflo(w.y); y[t * 8 + 3] += s * bfhi(w.y);
            y[t * 8 + 4] += s * bflo(w.z); y[t * 8 + 5] += s * bfhi(w.z); y[t * 8 + 6] += s * bflo(w.w); y[t * 8 + 7] += s * bfhi(w.w); }
    }
    LDS_WAIT(); asm volatile("" ::: "memory");
    { const float xi = __builtin_amdgcn_exp2f(gl2 * (float)(i + 1));
      const GAS v4u* sp = (const GAS v4u*)(ST + ((size_t)gc * 8 + h) * 2048);
#pragma unroll 1
      for (int e = 0; e < 64; ++e) { float s = 0.f;
#pragma unroll
        for (int t = 0; t < 4; ++t) { const v4u w = sp[e * 4 + t];
            s += q[t * 8 + 0] * bflo(w.x) + q[t * 8 + 1] * bfhi(w.x) + q[t * 8 + 2] * bflo(w.y) + q[t * 8 + 3] * bfhi(w.y) + q[t * 8 + 4] * bflo(w.z) + q[t * 8 + 5] * bfhi(w.z) + q[t * 8 + 6] * bflo(w.w) + q[t * 8 + 7] * bfhi(w.w); }
        SL[e * 64 + i] = s * xi; } }
    LDS_WAIT(); asm volatile("" ::: "memory");
    float mu = 0.f;
#pragma unroll
    for (int e = 0; e < 64; ++e) { y[e] += SL[e * 64 + i]; mu += y[e]; }
    mu *= (1.0f / 64.0f); float var = 0.f;
#pragma unroll
    for (int e = 0; e < 64; ++e) { y[e] -= mu; var += y[e] * y[e]; }
    const float r = 1.0f / sqrtf(var * (1.0f / 64.0f) + EPS);
    const GAS v4u* gp = (const GAS v4u*)(SG + row * 512 + h * 64); const GAS f32x4* wp = (const GAS f32x4*)(a.in[9] + h * 64);
    GAS v4u* op = (GAS v4u*)(MG + row * 1024 + 512 + h * 64);
#pragma unroll
    for (int t = 0; t < 8; ++t) { const v4u g = gp[t]; const f32x4 w0 = wp[2 * t], w1 = wp[2 * t + 1];
        v4u o; o.x = pk2(y[t * 8 + 0] * r * w0.x * bflo(g.x), y[t * 8 + 1] * r * w0.y * bfhi(g.x)); o.y = pk2(y[t * 8 + 2] * r * w0.z * bflo(g.y), y[t * 8 + 3] * r * w0.w * bfhi(g.y));
        o.z = pk2(y[t * 8 + 4] * r * w1.x * bflo(g.z), y[t * 8 + 5] * r * w1.y * bfhi(g.z)); o.w = pk2(y[t * 8 + 6] * r * w1.z * bflo(g.w), y[t * 8 + 7] * r * w1.w * bfhi(g.w));
        op[t] = o; asm volatile("" ::: "memory"); }
    LDS_WAIT(); __syncthreads();
}
__device__ __forceinline__ void p4_conv(Frame& F, const Args& a, int gc) {
    const bf16* U = (const bf16*)(a.ws + WS_U); bf16* MG = (bf16*)(a.ws + WS_RA);
    const int c = F.tid; const int t0 = (gc & (NCH - 1)) * 64; const size_t rowb = (size_t)(gc >> 7) * SEQ;
    LAS float* Y = (LAS float*)(F.lds + RING_OFF);
    LAS f32x2* STt = (LAS f32x2*)(F.lds + XS_OFF);
    float w[CONVW];
#pragma unroll
    for (int j = 0; j < CONVW; ++j) w[j] = a.in[5][j * CCH + c];
    const float cb = a.in[6][c];
    for (int blk = 0; blk < 8; ++blk) {
        const int tt = t0 + blk * 8; float uu[38];
#pragma unroll
        for (int k = 0; k < 38; ++k) { const int t = tt - 30 + k; uu[k] = (t >= 0) ? bf1(U[(rowb + t) * 512 + c]) : 0.f; }
#pragma unroll
        for (int o = 0; o < 8; ++o) { float s = cb;
#pragma unroll
            for (int j = 0; j < CONVW; ++j) s += w[j] * uu[o + j];
            Y[(blk * 8 + o) * 512 + c] = s; }
    }
    __syncthreads();
    for (int tk = 0; tk < 8; ++tk) { const int t = F.wave * 8 + tk; float v[8]; float s = 0.f;
#pragma unroll
        for (int k = 0; k < 8; ++k) { v[k] = Y[t * 512 + F.lane + 64 * k]; s += v[k]; }
        const float mean = wave_sum(s) * (1.0f / 512.0f); float s2 = 0.f;
#pragma unroll
        for (int k = 0; k < 8; ++k) { const float dd = v[k] - mean; s2 += dd * dd; }
        const float rstd = 1.0f / sqrtf(wave_sum(s2) * (1.0f / 512.0f) + EPS);
        if (F.lane == 0) STt[t] = (f32x2){mean, rstd}; }
    __syncthreads();
    const float lw = a.in[7][c], lb = a.in[8][c];
    for (int t = 0; t < 64; ++t) { const f32x2 st = STt[t]; const float yn = (Y[t * 512 + c] - st.x) * st.y * lw + lb;
        MG[(rowb + t0 + t) * 1024 + c] = (bf16)f2bf(yn * fast_sigmoid(yn)); }
    __syncthreads();
}
__device__ __forceinline__ void p12_final(Frame& F, const Args& a) {
    const int gw = F.vcu * NWAVES + F.wave, NGW = F.G * NWAVES;
    const GAS f32x4* wr = (const GAS f32x4*)a.in[19] + F.lane;
    f32x4 w[4];
#pragma unroll
    for (int j = 0; j < 4; ++j) w[j] = wr[64 * j];
    for (int m = gw; m < M; m += NGW) {
        GAS f32x4* xr = (GAS f32x4*)(a.out + (size_t)m * D) + F.lane;
        f32x4 v[4]; float s = 0.f;
#pragma unroll
        for (int j = 0; j < 4; ++j) { v[j] = xr[64 * j]; s += (v[j].x * v[j].x + v[j].y * v[j].y) + (v[j].z * v[j].z + v[j].w * v[j].w); }
        const float rstd = 1.0f / sqrtf(wave_sum(s) * (1.0f / D) + EPS);
#pragma unroll
        for (int j = 0; j < 4; ++j) xr[64 * j] = v[j] * rstd * w[j];
    }
}

__global__ void __launch_bounds__(NWAVES * 64, 2) fwd_kernel(Args args) {
    extern __shared__ __attribute__((aligned(16))) unsigned char lds[];
    Frame F;
    F.lds = (LAS unsigned char*)lds;
    volatile LAS unsigned* MISC = (volatile LAS unsigned*)(F.lds + MISC_OFF);
    F.tid = threadIdx.x; F.lane = F.tid & 63; F.wave = __builtin_amdgcn_readfirstlane(F.tid >> 6);
    F.G = gridDim.x; { const int bx = blockIdx.x; F.vcu = (F.G % 8 == 0) ? (bx % 8) * (F.G / 8) + bx / 8 : bx; }
    unsigned char* ws = args.ws;
    gu32* ctl = (gu32*)(ws + WS_CTL);
    for (int u = F.tid; u < 256; u += NWAVES * 64) ((LAS unsigned*)(F.lds + LDSCTL_OFF))[u] = 0u;
    __syncthreads();
    XcdBarrier bar; bar.bar = (unsigned*)(ctl + CW_BAR); bar.x = 0; bar.st = nullptr;
    if (N_LAUNCHES == 1) bar = xcd_barrier_post((unsigned*)(ctl + CW_BAR), MISC + 8);
#define GRID_BAR() do { if (N_LAUNCHES == 1) xcd_barrier(bar); } while (0)
    const int lo = args.ph_lo, hi = args.ph_hi;
#define IN(k) (lo <= (k) && (k) < hi)
    const int c = (int)blockIdx.x;
    LAS unsigned char* ring = F.lds + RING_OFF;
    float* rss1 = (float*)(ws + WS_CTL + CTL_RSS1); float* rss2 = (float*)(ws + WS_CTL + CTL_RSS2);

    if (IN(0)) { p0_prologue(F, args); GRID_BAR(); }
    if (IN(1)) {
        SchedIn S{(const char*)(ws + WS_E), F.G, c};
        EpiIn E{(bf16*)(ws + WS_U), (bf16*)(ws + WS_QK), (bf16*)(ws + WS_V), (bf16*)(ws + WS_SG), (bf16*)(ws + WS_KMEM), (bf16*)(ws + WS_VT), (const float*)(ws + WS_RS0), (const float*)(ws + WS_COS), (const float*)(ws + WS_SIN)};
        pg8::gemm_phase(ring, pg8::Shape{D, D, D}, S, E);
        GRID_BAR();
    }
    if (IN(2)) { p2_kv(F, args); GRID_BAR(); }
    if (IN(3)) { p3_scan(F, args); GRID_BAR(); }
    if (IN(4)) {
        for (int u = F.vcu; u < 2 * NCHUNKS; u += F.G) { if (u < NCHUNKS) p4_conv(F, args, u); else p4_ret(F, args, u - NCHUNKS); }
        GRID_BAR();
    }
    if (IN(5)) {
        SchedPlain S{(const char*)(ws + WS_RA), (const char*)(ws + WS_WOUT), TS, TS, 64, 4, F.G, c};
        EpiRes E{args.in[0], args.out, (bf16*)(ws + WS_HB), rss1};
        pg8::gemm_phase(ring, pg8::Shape{D, D, D}, S, E);
        GRID_BAR();
    }
    if (IN(6)) {
        SchedPlain S{(const char*)(ws + WS_HB), (const char*)(ws + WS_WQ), TS, TS, 64, 4, F.G, c};
        EpiScale<0> E{(bf16*)(ws + WS_RA), D, rss1};
        pg8::gemm_phase(ring, pg8::Shape{D, D, D}, S, E);
        GRID_BAR();
    }
    if (IN(7)) {
        SchedAttn S{(const char*)(ws + WS_RA), (const char*)(ws + WS_KMEM), (size_t)256 * 1024 * 2, (size_t)512, F.G, c};
        EpiSoftmax E{(bf16*)(ws + WS_P)};
        pg8::gemm_phase(ring, pg8::Shape{256, D, D}, S, E);
        GRID_BAR();
    }
    if (IN(8)) {
        SchedAttn S{(const char*)(ws + WS_P), (const char*)(ws + WS_VT), (size_t)512, (size_t)256 * 512 * 2, F.G, c};
        EpiPlain E{(bf16*)(ws + WS_RA), D};
        pg8::gemm_phase(ring, pg8::Shape{256, D, 512}, S, E);
        GRID_BAR();
    }
    if (IN(9)) {
        SchedPlain S{(const char*)(ws + WS_RA), (const char*)(ws + WS_WO), TS, TS, 64, 4, F.G, c};
        EpiRes E{args.out, args.out, (bf16*)(ws + WS_HB), rss2};
        pg8::gemm_phase(ring, pg8::Shape{D, D, D}, S, E);
        GRID_BAR();
    }
    if (IN(10)) {
        SchedPlain S{(const char*)(ws + WS_HB), (const char*)(ws + WS_WUP), TS, TS, 64, 16, F.G, c};
        EpiScale<1> E{(bf16*)(ws + WS_HID), FF, rss2};
        pg8::gemm_phase(ring, pg8::Shape{D, D, D}, S, E);
        GRID_BAR();
    }
    if (IN(11)) {
        SchedPlain S{(const char*)(ws + WS_HID), (const char*)(ws + WS_WDN), (size_t)256 * FF * 2, (size_t)256 * FF * 2, 64, 4, F.G, c};
        EpiRes E{args.out, args.out, nullptr, nullptr};
        pg8::gemm_phase(ring, pg8::Shape{FF, FF, FF}, S, E);
        GRID_BAR();
    }
    if (IN(12)) { p12_final(F, args); }
#undef IN
#undef GRID_BAR
}

extern "C" void kernel_launch(void* const* d_in, const int* in_sizes, int n_in, void* d_out, int out_size, void* d_ws, size_t ws_size, hipStream_t stream) {
    static int grid = 0;
    if (grid == 0) {
        if (n_in != 20 || in_sizes[0] != M * D || out_size != M * D || ws_size < WS_END) { fprintf(stderr, "kernel_launch: unexpected problem shape (n_in %d, in0 %d, out %d, ws %zu); nothing launched\n", n_in, n_in > 0 ? in_sizes[0] : -1, out_size, ws_size); grid = -1; return; }
        int dev = 0, cus = 0;
        if (hipGetDevice(&dev) != hipSuccess || hipDeviceGetAttribute(&cus, hipDeviceAttributeMultiprocessorCount, dev) != hipSuccess) { grid = -1; return; }
        if (hipFuncSetAttribute((const void*)fwd_kernel, hipFuncAttributeMaxDynamicSharedMemorySize, LDS_BYTES) != hipSuccess) { fprintf(stderr, "kernel_launch: hipFuncSetAttribute failed\n"); grid = -1; return; }
        int per_cu = 0;
        if (hipOccupancyMaxActiveBlocksPerMultiprocessor(&per_cu, (const void*)fwd_kernel, NWAVES * 64, LDS_BYTES) != hipSuccess || per_cu < 1)
            fprintf(stderr, "kernel_launch: note: occupancy query reports %d workgroups per CU\n", per_cu);
        (void)hipGetLastError();
        grid = cus;
    }
    if (grid < 0) return;
    if (hipMemsetAsync((char*)d_ws + WS_CTL, 0, CTL_ZERO_BYTES, stream) != hipSuccess) { fprintf(stderr, "kernel_launch: hipMemsetAsync failed\n"); return; }
    Args a{};
    for (int i = 0; i < 20; ++i) a.in[i] = (const float*)d_in[i];
    a.out = (float*)d_out; a.ws = (unsigned char*)d_ws;
    for (int i = 0; i < 16; ++i) a.inv_freq[i] = (float)std::pow(10000.0, -(double)i / 16.0);
    for (int h = 0; h < 8; ++h) { const double lg = std::log1p(-std::exp2(-5.0 - (double)h)); a.gl2[h] = (float)(lg / std::log(2.0)); a.g64[h] = (float)std::exp(64.0 * lg); }
    for (int li = 0; li < N_LAUNCHES; ++li) {
        a.ph_lo = (N_LAUNCHES == 1) ? 0 : li; a.ph_hi = (N_LAUNCHES == 1) ? N_PHASES : li + 1; a.li = li;
        hipLaunchKernelGGL(fwd_kernel, dim3(grid), dim3(NWAVES * 64), LDS_BYTES, stream, a);
        const hipError_t le = hipPeekAtLastError();
        if (le != hipSuccess) { fprintf(stderr, "kernel_launch: launch %d failed: %s\n", li, hipGetErrorName(le)); break; }
    }
}
```

```cpp
#include <hip/hip_runtime.h>
#include <cstdio>
#include <cstdint>
#include <cmath>

#ifndef MK_N_LAUNCHES
#define MK_N_LAUNCHES 1
#endif

namespace pg8 {
#define PG8_LAS __attribute__((address_space(3)))
typedef unsigned short bf16_t;
typedef short bf16x8 __attribute__((ext_vector_type(8)));
typedef float f32x4 __attribute__((ext_vector_type(4)));
typedef unsigned u32x4 __attribute__((ext_vector_type(4)));
constexpr int BM = 256, BK = 64, HALF = 128, HTB = HALF * BK * 2, STAGE_BYTES = 8 * HTB, NXCD = 8, WGM = 8;

__host__ __device__ __forceinline__ int lds_byte(int r, int c) { const int st = (r >> 4) * 2 + (c >> 5), rr = r & 15, cc = c & 31, ob = rr * 64 + cc * 2; return st * 1024 + (ob ^ (((ob >> 9) & 1) << 5)); }
__host__ __device__ __forceinline__ void stage_rc(int b, int& R, int& C) { const int st = b / 1024, sb = b % 1024, swz = sb ^ (((sb >> 9) & 1) << 5); R = (st >> 1) * 16 + swz / 64; C = (st & 1) * 32 + (swz % 64) / 2; }
__host__ __device__ __forceinline__ int perm32(int rho) { const int n = rho >> 4, i = rho & 15; return 8 * (i >> 2) + 4 * n + (i & 3); }

struct Unit { const char* a; const char* b; int pm, pn; };
struct Shape { int K, lda, ldb; };

__device__ __forceinline__ void tile_map(int L, int nM, int nN, int& pm, int& pn) {
    const int nwg = nM * nN; int wgid = L;
    { const int q = nwg / NXCD, r = nwg % NXCD, xcd = wgid % NXCD, off = wgid / NXCD; wgid = (xcd < r ? xcd * (q + 1) : r * (q + 1) + (xcd - r) * q) + off; }
    const int nig = WGM * nN, gid = wgid / nig, fm = gid * WGM, gsz = (nM - fm) < WGM ? (nM - fm) : WGM;
    pm = fm + ((wgid % nig) % gsz); pn = (wgid % nig) / gsz;
}

__device__ __forceinline__ unsigned cvt_pk_bf16(float lo, float hi) { unsigned r; asm volatile("v_cvt_pk_bf16_f32 %0, %1, %2" : "=v"(r) : "v"(lo), "v"(hi)); return r; }
__device__ __forceinline__ u32x4 pack8(const f32x4 v0, const f32x4 v1) { u32x4 w; w.x = cvt_pk_bf16(v0[0], v0[1]); w.y = cvt_pk_bf16(v0[2], v0[3]); w.z = cvt_pk_bf16(v1[0], v1[1]); w.w = cvt_pk_bf16(v1[2], v1[3]); return w; }

typedef f32x4 Acc[2][2][4][2];

template <class Epi, class Sched>
__device__ __forceinline__ void gemm_phase(PG8_LAS unsigned char* lds, const Shape g, const Sched& S, const Epi& E) {
    const int tid = threadIdx.x, wid = __builtin_amdgcn_readfirstlane(tid >> 6), lane = tid & 63, wr = wid >> 2, wc = wid & 3, fr = lane & 15, fq = lane >> 4;
    int K = g.K; asm volatile("" : "+s"(K)); const int nt = K / BK;
    unsigned voffA[2], voffB[2];
#pragma unroll
    for (int i = 0; i < 2; ++i) { int R, C; stage_rc(tid * 16 + i * 8192, R, C); const int Rb = (R & ~31) + perm32(R & 31);
        voffA[i] = (unsigned)(R * g.lda + C) * 2u; voffB[i] = (unsigned)(Rb * g.ldb + C) * 2u; }
    const size_t kstep = (size_t)(BK * 2);
    const size_t hstepA = (size_t)HALF * g.lda * 2, hstepB = (size_t)HALF * g.ldb * 2;
    const unsigned ldsw = (unsigned)wid * 1024u;
    const int aoff = lds_byte(wr * 64 + fr, fq * 8), boff = lds_byte(wc * 32 + fr, fq * 8);
#define PG8_SA(b, h) (((b) * 2 + (h)) * HTB)
#define PG8_SB(b, h) ((4 + (b) * 2 + (h)) * HTB)
#define PG8_STAGE(bufoff, gbase, voff) do { _Pragma("unroll") for (int _i = 0; _i < 2; ++_i) \
        __builtin_amdgcn_global_load_lds((const unsigned*)((const char*)(gbase) + (voff)[_i]), (PG8_LAS unsigned*)(lds + (bufoff) + ldsw + _i * 8192), 16, 0, 0); } while (0)
#define PG8_LDA(dst, b, h) do { _Pragma("unroll") for (int m = 0; m < 4; ++m) _Pragma("unroll") for (int k = 0; k < 2; ++k) dst[m][k] = *(const PG8_LAS bf16x8*)(lds + PG8_SA(b, h) + aoff + m * 2048 + k * 1024); } while (0)
#define PG8_LDB(dst, b, h) do { _Pragma("unroll") for (int n = 0; n < 2; ++n) _Pragma("unroll") for (int k = 0; k < 2; ++k) dst[n][k] = *(const PG8_LAS bf16x8*)(lds + PG8_SB(b, h) + boff + n * 2048 + k * 1024); } while (0)
#define PG8_MMA(ai, bj, At, Bt) do { __builtin_amdgcn_s_setprio(1); _Pragma("unroll") for (int m = 0; m < 4; ++m) _Pragma("unroll") for (int n = 0; n < 2; ++n) _Pragma("unroll") for (int k = 0; k < 2; ++k) \
        acc[ai][bj][m][n] = __builtin_amdgcn_mfma_f32_16x16x32_bf16(Bt[n][k], At[m][k], acc[ai][bj][m][n], 0, 0, 0); __builtin_amdgcn_s_setprio(0); } while (0)
#define PG8_WAIT_V(n) asm volatile("s_waitcnt vmcnt(" #n ")" ::: "memory")
#define PG8_WAIT_L(n) asm volatile("s_waitcnt lgkmcnt(" #n ")" ::: "memory")
#define PG8_BAR __builtin_amdgcn_s_barrier()
#define PG8_SCHED __builtin_amdgcn_sched_barrier(0)
    Unit cur, nxt; int ui = 0;
    if (!S.next(0, cur)) return;
    Acc acc;
#pragma unroll
    for (int a = 0; a < 2; ++a)
#pragma unroll
        for (int b = 0; b < 2; ++b)
#pragma unroll
            for (int m = 0; m < 4; ++m)
#pragma unroll
                for (int n = 0; n < 2; ++n) acc[a][b][m][n] = (f32x4){0.f, 0.f, 0.f, 0.f};
    bf16x8 At[4][2], B0[2][2], B1[2][2];
    const char* cA = cur.a; const char* cB = cur.b;
    PG8_STAGE(PG8_SB(0, 0), cB, voffB); PG8_STAGE(PG8_SB(0, 1), cB + hstepB, voffB); PG8_STAGE(PG8_SA(0, 0), cA, voffA); PG8_STAGE(PG8_SA(0, 1), cA + hstepA, voffA);
    if (wr == 1) PG8_BAR;
    PG8_WAIT_V(2); PG8_BAR;
    PG8_STAGE(PG8_SB(1, 0), cB + kstep, voffB); PG8_STAGE(PG8_SA(1, 0), cA + kstep, voffA); PG8_STAGE(PG8_SB(1, 1), cB + hstepB + kstep, voffB);
    PG8_WAIT_V(6); PG8_BAR;
    for (;;) {
        const bool has_next = S.next(ui + 1, nxt);
        const char* nA = has_next ? nxt.a : cA; const char* nB = has_next ? nxt.b : cB;
        for (int t = 0; t < nt; t += 2) {
            const bool last = (t == nt - 2);
            const char* a1 = cA + (size_t)(t + 1) * kstep;
            const char* a2 = last ? nA : cA + (size_t)(t + 2) * kstep; const char* b2 = last ? nB : cB + (size_t)(t + 2) * kstep;
            const char* a3 = a2 + kstep; const char* b3 = b2 + kstep;
            PG8_LDB(B0, 0, 0); PG8_LDB(B1, 0, 1); PG8_SCHED; PG8_LDA(At, 0, 0); PG8_STAGE(PG8_SA(1, 1), a1 + hstepA, voffA);
            PG8_WAIT_V(8); PG8_WAIT_L(0); PG8_BAR; PG8_MMA(0, 0, At, B0); PG8_MMA(0, 1, At, B1); PG8_BAR; PG8_SCHED;
            PG8_LDA(At, 0, 1); PG8_STAGE(PG8_SB(0, 0), b2, voffB); PG8_STAGE(PG8_SB(0, 1), b2 + hstepB, voffB); PG8_STAGE(PG8_SA(0, 0), a2, voffA);
            PG8_WAIT_V(8); PG8_WAIT_L(0); PG8_BAR; PG8_MMA(1, 0, At, B0); PG8_MMA(1, 1, At, B1); PG8_BAR; PG8_SCHED;
            PG8_LDB(B0, 1, 0); PG8_LDB(B1, 1, 1); PG8_SCHED; PG8_LDA(At, 1, 0); PG8_STAGE(PG8_SA(0, 1), a2 + hstepA, voffA);
            PG8_WAIT_V(8); PG8_WAIT_L(0); PG8_BAR; PG8_MMA(0, 0, At, B0); PG8_MMA(0, 1, At, B1); PG8_BAR; PG8_SCHED;
            PG8_LDA(At, 1, 1); PG8_STAGE(PG8_SB(1, 0), b3, voffB); PG8_STAGE(PG8_SB(1, 1), b3 + hstepB, voffB); PG8_STAGE(PG8_SA(1, 0), a3, voffA);
            PG8_WAIT_V(8); PG8_WAIT_L(0); PG8_BAR; PG8_MMA(1, 0, At, B0); PG8_MMA(1, 1, At, B1); PG8_BAR; PG8_SCHED;
        }
        if (wr == 0) PG8_BAR;
        E(acc, cur, wr, wc, fr, fq, lds);
        if (!has_next) break;
#pragma unroll
        for (int a = 0; a < 2; ++a)
#pragma unroll
            for (int b = 0; b < 2; ++b)
#pragma unroll
                for (int m = 0; m < 4; ++m)
#pragma unroll
                    for (int n = 0; n < 2; ++n) acc[a][b][m][n] = (f32x4){0.f, 0.f, 0.f, 0.f};
        cur = nxt; cA = nA; cB = nB; ++ui;
        if (wr == 1) PG8_BAR;
    }
    PG8_WAIT_V(0);
    PG8_BAR;
#undef PG8_SA
#undef PG8_SB
#undef PG8_STAGE
#undef PG8_LDA
#undef PG8_LDB
#undef PG8_MMA
#undef PG8_WAIT_V
#undef PG8_WAIT_L
#undef PG8_BAR
#undef PG8_SCHED
}
}

constexpr int NWAVES = 8;
constexpr int N_LAUNCHES = MK_N_LAUNCHES;
constexpr int N_PHASES = 13;
constexpr int BATCH = 2, SEQ = 8192, D = 1024, M = BATCH * SEQ, DIN = 2560, FF = 4096, NMEM = 256, MROWS = BATCH * NMEM;
constexpr int CCH = 512, CONVW = 31, RH = 8, DK = 32, DV = 64, CHUNK = 64, NCH = SEQ / CHUNK, NCHUNKS = M / CHUNK;
constexpr float EPS = 1e-6f;
constexpr float LOG2E = 1.4426950408889634f;

constexpr size_t MiB = 1u << 20;
constexpr size_t WS_CTL = 0, CTL_ZERO_BYTES = 1 * MiB;
constexpr size_t CTL_RSS1 = 256 * 1024, CTL_RSS2 = 320 * 1024;
constexpr size_t WS_COS = 2 * MiB, WS_SIN = 3 * MiB;
constexpr size_t WS_RS0 = 4 * MiB;
constexpr size_t WS_KMEM = 5 * MiB, WS_VT = 6 * MiB;
constexpr size_t WS_WOUT = 8 * MiB, WS_WQ = 10 * MiB, WS_WO = 12 * MiB, WS_WUP = 14 * MiB, WS_WDN = 22 * MiB;
constexpr size_t WS_E = 40 * MiB;
constexpr size_t WS_XB = WS_E, WS_MEMN = WS_E + 32 * MiB, WS_WIN = WS_E + 33 * MiB, WS_WKV = WS_E + 38 * MiB;
constexpr size_t WS_RA = 40 * MiB;
constexpr size_t WS_RB = 82 * MiB;
constexpr size_t WS_U = WS_RB, WS_QK = WS_RB + 16 * MiB, WS_V = WS_RB + 32 * MiB, WS_SG = WS_RB + 48 * MiB;
constexpr size_t WS_HB = WS_RB;
constexpr size_t WS_P = WS_RB + 32 * MiB;
constexpr size_t WS_KVT = 146 * MiB;
constexpr size_t WS_ST = 162 * MiB;
constexpr size_t WS_HID = 128 * MiB;
constexpr size_t WS_END = 256 * MiB;
constexpr int CW_TMO = 0, CW_CODE = 1, CW_BAR = 4096;

constexpr int RING_OFF = 0, RING_BYTES = 131072;
constexpr int LDSCTL_OFF = RING_BYTES, MISC_OFF = LDSCTL_OFF + 320;
constexpr int XS_OFF = RING_BYTES + 1024;
constexpr int LDS_BYTES = 147456;

#define GAS __attribute__((address_space(1)))
#define LAS __attribute__((address_space(3)))
typedef unsigned short bf16;
typedef unsigned v4u __attribute__((ext_vector_type(4)));
typedef float f32x4 __attribute__((ext_vector_type(4)));
typedef float f32x2 __attribute__((ext_vector_type(2)));
typedef GAS unsigned gu32;
#define RLX_AGENT __ATOMIC_RELAXED, __HIP_MEMORY_SCOPE_AGENT
#define LDS_WAIT() asm volatile("s_waitcnt lgkmcnt(0)" ::: "memory")
#define VM_WAIT() asm volatile("s_waitcnt vmcnt(0)" ::: "memory")
__device__ __forceinline__ unsigned f2bf(float f) { unsigned u = __builtin_bit_cast(unsigned, f); return (u + 0x7fffu + ((u >> 16) & 1u)) >> 16; }
__device__ __forceinline__ unsigned pk2(float lo, float hi) { return f2bf(lo) | (f2bf(hi) << 16); }
__device__ __forceinline__ float bflo(unsigned w) { return __uint_as_float(w << 16); }
__device__ __forceinline__ float bfhi(unsigned w) { return __uint_as_float(w & 0xffff0000u); }
__device__ __forceinline__ float bf1(bf16 b) { return __uint_as_float((unsigned)b << 16); }
__device__ __forceinline__ float fast_sigmoid(float x) { return __builtin_amdgcn_rcpf(1.0f + __builtin_amdgcn_exp2f(-x * LOG2E)); }
__device__ __forceinline__ float wave_sum(float v) {
#pragma unroll
    for (int o = 1; o < 64; o <<= 1) v += __shfl_xor(v, o);
    return v;
}

#define XB_TMO      128
#define XB_XCNT(j)  (256  + 64 * (j))
#define XB_XSUB(j)  (1280 + 64 * (j))
#define XB_XGEN(j)  (2304 + 64 * (j))
#define XB_TOP      3328
#define XB_TOPGEN   3392
#define XCD_BAR_WORDS 3456
#define XB_SPIN_CAP (1u << 18)
__device__ __forceinline__ unsigned xb_ld(unsigned* p)              { return __hip_atomic_load(p, __ATOMIC_RELAXED, __HIP_MEMORY_SCOPE_AGENT); }
__device__ __forceinline__ unsigned xb_add(unsigned* p, unsigned v) { return __hip_atomic_fetch_add(p, v, __ATOMIC_RELAXED, __HIP_MEMORY_SCOPE_AGENT); }
__device__ __forceinline__ unsigned xb_xcc_id() { return (unsigned)__builtin_amdgcn_s_getreg((3 << 11) | 20) & 0xFu; }
#define XB_SPIN(cond, bar) do { unsigned _sp = 0; while (cond) { __builtin_amdgcn_s_sleep(1); \
    if ((++_sp & 255u) == 0u) { if (xb_ld(&(bar)[XB_TMO])) break; if (_sp > XB_SPIN_CAP) { atomicAdd(&(bar)[XB_TMO], 1u); break; } } } } while (0)
struct XcdBarrier { unsigned* bar; unsigned x; volatile LAS unsigned* st; };
__device__ __forceinline__ XcdBarrier xcd_barrier_post(unsigned* bar, volatile LAS unsigned* st) {
    XcdBarrier b; b.bar = bar; b.x = xb_xcc_id(); b.st = st;
    if (threadIdx.x == 0) (void)xb_add(&bar[XB_XCNT(b.x)], 1u);
    return b;
}
__device__ __forceinline__ void xcd_barrier_complete(unsigned* bar, unsigned x, unsigned& nloc, unsigned& nx) {
    const unsigned G = gridDim.x * gridDim.y * gridDim.z;
    unsigned sum, cnt, mine, sp = 0u;
    for (;;) {
        sum = 0u; cnt = 0u; mine = 0u;
#pragma unroll
        for (unsigned j = 0; j < 16; ++j) { const unsigned c = xb_ld(&bar[XB_XCNT(j)]); sum += c; cnt += (c > 0u) ? 1u : 0u; mine = (j == x) ? c : mine; }
        if (sum == G) break;
        __builtin_amdgcn_s_sleep(1);
        if ((++sp & 255u) == 0u) { if (xb_ld(&bar[XB_TMO])) break; if (sp > XB_SPIN_CAP) { atomicAdd(&bar[XB_TMO], 1u); break; } }
    }
    nloc = mine > 0u ? mine : 1u; nx = cnt > 0u ? cnt : 1u;
}
__device__ __forceinline__ void xcd_barrier(const XcdBarrier& b) {
    asm volatile("s_waitcnt vmcnt(0)" ::: "memory");
    __syncthreads();
    if (threadIdx.x == 0) {
        unsigned* bar = b.bar;
        __builtin_amdgcn_s_waitcnt(0);
        unsigned nloc = b.st[0], nx = b.st[1];
        if (nloc == 0u) { xcd_barrier_complete(bar, b.x, nloc, nx); b.st[0] = nloc; b.st[1] = nx; }
        const unsigned old = xb_add(&bar[XB_XSUB(b.x)], 1u);
        const unsigned gen = old / nloc;
        if (old + 1u == (gen + 1u) * nloc) {
            __builtin_amdgcn_fence(__ATOMIC_RELEASE, "agent");
            asm volatile("s_waitcnt vmcnt(0)" ::: "memory");
            const unsigned og = xb_add(&bar[XB_TOP], 1u);
            const unsigned tg = og / nx;
            if (og + 1u == (tg + 1u) * nx) xb_add(&bar[XB_TOPGEN], 1u);
            else XB_SPIN(xb_ld(&bar[XB_TOPGEN]) == tg, bar);
            __builtin_amdgcn_fence(__ATOMIC_ACQUIRE, "agent");
            xb_add(&bar[XB_XGEN(b.x)], 1u);
            asm volatile("s_waitcnt vmcnt(0)" ::: "memory");
        } else {
            XB_SPIN(xb_ld(&bar[XB_XGEN(b.x)]) == gen, bar);
            __builtin_amdgcn_fence(__ATOMIC_ACQUIRE, "agent");
            asm volatile("s_waitcnt vmcnt(0)" ::: "memory");
        }
    }
    __syncthreads();
}

struct Args { const float* in[20]; float* out; unsigned char* ws; float inv_freq[16]; float gl2[8]; float g64[8]; int ph_lo, ph_hi, li, pad; };
struct Frame {
    LAS unsigned char* lds;
    int tid, lane, wave, vcu, G;
};

using pg8::Acc; using pg8::Unit; using pg8::pack8;
struct EpiIn {
    bf16 *U, *QK, *V, *SG, *KM, *VT; const float* rs0; const float* cosT; const float* sinT;
    __device__ __forceinline__ void operator()(Acc& acc, const Unit& u, int wr, int wc, int fr, int fq, LAS unsigned char*) const {
        const int t = u.pn, cl = wc * 32 + 8 * fq;
        if (t < 4) {
#pragma unroll
            for (int ai = 0; ai < 2; ++ai)
#pragma unroll
                for (int m = 0; m < 4; ++m) { const int row = u.pm * 256 + ai * 128 + wr * 64 + m * 16 + fr; const float rs = rs0[row];
                    f32x4 o0, o1;
#pragma unroll
                    for (int j = 0; j < 4; ++j) { o0[j] = acc[ai][0][m][0][j] * rs * fast_sigmoid(acc[ai][1][m][0][j] * rs); o1[j] = acc[ai][0][m][1][j] * rs * fast_sigmoid(acc[ai][1][m][1][j] * rs); }
                    *(v4u*)(U + (size_t)row * 512 + t * 128 + cl) = pack8(o0, o1); }
        } else if (t < 6) {
            const float sc = (t == 4) ? 0.17677669529663687f : 1.0f;
#pragma unroll
            for (int ai = 0; ai < 2; ++ai)
#pragma unroll
                for (int m = 0; m < 4; ++m) { const int row = u.pm * 256 + ai * 128 + wr * 64 + m * 16 + fr; const float rs = rs0[row] * sc;
                    const f32x4 c4 = *(const f32x4*)(cosT + (size_t)row * 16 + 4 * fq), s4 = *(const f32x4*)(sinT + (size_t)row * 16 + 4 * fq);
#pragma unroll
                    for (int bj = 0; bj < 2; ++bj) { const f32x4 t1 = acc[ai][bj][m][0] * rs, t2 = acc[ai][bj][m][1] * rs;
                        const f32x4 o1 = t1 * c4 - t2 * s4, o2 = t1 * s4 + t2 * c4;
                        *(v4u*)(QK + (size_t)row * 512 + (t - 4) * 256 + bj * 128 + cl) = pack8(o1, o2); } }
        } else if (t < 10) {
            bf16* O = (t < 8) ? V : SG; const int c0 = ((t - 6) & 1) * 256; const bool act = (t >= 8);
#pragma unroll
            for (int ai = 0; ai < 2; ++ai)
#pragma unroll
                for (int m = 0; m < 4; ++m) { const int row = u.pm * 256 + ai * 128 + wr * 64 + m * 16 + fr; const float rs = rs0[row];
#pragma unroll
                    for (int bj = 0; bj < 2; ++bj) { f32x4 v0 = acc[ai][bj][m][0] * rs, v1 = acc[ai][bj][m][1] * rs;
                        if (act) {
#pragma unroll
                            for (int j = 0; j < 4; ++j) { v0[j] = v0[j] * fast_sigmoid(v0[j]); v1[j] = v1[j] * fast_sigmoid(v1[j]); } }
                        *(v4u*)(O + (size_t)row * 512 + c0 + bj * 128 + cl) = pack8(v0, v1); } }
        } else {
            bf16* O = (t < 14) ? KM : VT; const int ldc = (t < 14) ? 1024 : 512; const int c0 = ((t < 14) ? (t - 10) : (t - 14)) * 256;
#pragma unroll
            for (int ai = 0; ai < 2; ++ai)
#pragma unroll
                for (int m = 0; m < 4; ++m) { const int row = u.pm * 256 + ai * 128 + wr * 64 + m * 16 + fr;
#pragma unroll
                    for (int bj = 0; bj < 2; ++bj) *(v4u*)(O + (size_t)row * ldc + c0 + bj * 128 + cl) = pack8(acc[ai][bj][m][0], acc[ai][bj][m][1]); }
        }
    }
};
struct EpiRes {
    const float* base; float* out; bf16* outb; float* rss;
    __device__ __forceinline__ void operator()(Acc& acc, const Unit& u, int wr, int wc, int fr, int fq, LAS unsigned char*) const {
        const int cl = u.pn * 256 + wc * 32 + 8 * fq;
#pragma unroll
        for (int ai = 0; ai < 2; ++ai)
#pragma unroll
            for (int m = 0; m < 4; ++m) { const int row = u.pm * 256 + ai * 128 + wr * 64 + m * 16 + fr; float ss = 0.f;
#pragma unroll
                for (int bj = 0; bj < 2; ++bj) { const size_t off = (size_t)row * D + cl + bj * 128;
                    const f32x4 v0 = acc[ai][bj][m][0] + *(const f32x4*)(base + off), v1 = acc[ai][bj][m][1] + *(const f32x4*)(base + off + 4);
                    *(f32x4*)(out + off) = v0; *(f32x4*)(out + off + 4) = v1;
                    if (outb) *(v4u*)(outb + off) = pack8(v0, v1);
                    ss += (v0[0] * v0[0] + v0[1] * v0[1]) + (v0[2] * v0[2] + v0[3] * v0[3]) + (v1[0] * v1[0] + v1[1] * v1[1]) + (v1[2] * v1[2] + v1[3] * v1[3]); }
                if (rss) { ss += __shfl_xor(ss, 16); ss += __shfl_xor(ss, 32); if (fq == 0) atomicAdd(rss + row, ss); } }
    }
};
template <int ACT> struct EpiScale {
    bf16* O; int ldc; const float* rss;
    __device__ __forceinline__ void operator()(Acc& acc, const Unit& u, int wr, int wc, int fr, int fq, LAS unsigned char*) const {
        const int cl = u.pn * 256 + wc * 32 + 8 * fq;
#pragma unroll
        for (int ai = 0; ai < 2; ++ai)
#pragma unroll
            for (int m = 0; m < 4; ++m) { const int row = u.pm * 256 + ai * 128 + wr * 64 + m * 16 + fr; const float rs = 1.0f / sqrtf(rss[row] * (1.0f / D) + EPS);
#pragma unroll
                for (int bj = 0; bj < 2; ++bj) { f32x4 v0 = acc[ai][bj][m][0] * rs, v1 = acc[ai][bj][m][1] * rs;
                    if (ACT == 1) {
#pragma unroll
                        for (int j = 0; j < 4; ++j) { const float a = fmaxf(v0[j], 0.f), b = fmaxf(v1[j], 0.f); v0[j] = a * a; v1[j] = b * b; } }
                    *(v4u*)(O + (size_t)row * ldc + cl + bj * 128) = pack8(v0, v1); } }
    }
};
struct EpiPlain {
    bf16* O; int ldc;
    __device__ __forceinline__ void operator()(Acc& acc, const Unit& u, int wr, int wc, int fr, int fq, LAS unsigned char*) const {
        const int cl = u.pn * 256 + wc * 32 + 8 * fq;
#pragma unroll
        for (int ai = 0; ai < 2; ++ai)
#pragma unroll
            for (int m = 0; m < 4; ++m) { const int row = u.pm * 256 + ai * 128 + wr * 64 + m * 16 + fr;
#pragma unroll
                for (int bj = 0; bj < 2; ++bj) *(v4u*)(O + (size_t)row * ldc + cl + bj * 128) = pack8(acc[ai][bj][m][0], acc[ai][bj][m][1]); }
    }
};
struct EpiSoftmax {
    bf16* O;
    __device__ __forceinline__ void operator()(Acc& acc, const Unit& u, int wr, int wc, int fr, int fq, LAS unsigned char* lds) const {
        LAS f32x2* X = (LAS f32x2*)(lds + XS_OFF);
        const float sc = 0.0625f * LOG2E;
#pragma unroll
        for (int ai = 0; ai < 2; ++ai)
#pragma unroll
            for (int m = 0; m < 4; ++m) { float mx = -3.0e38f;
#pragma unroll
                for (int bj = 0; bj < 2; ++bj)
#pragma unroll
                    for (int n = 0; n < 2; ++n)
#pragma unroll
                        for (int j = 0; j < 4; ++j) mx = fmaxf(mx, acc[ai][bj][m][n][j]);
                mx = fmaxf(mx, __shfl_xor(mx, 16)); mx = fmaxf(mx, __shfl_xor(mx, 32));
                float s = 0.f;
#pragma unroll
                for (int bj = 0; bj < 2; ++bj)
#pragma unroll
                    for (int n = 0; n < 2; ++n)
#pragma unroll
                        for (int j = 0; j < 4; ++j) { const float e = __builtin_amdgcn_exp2f((acc[ai][bj][m][n][j] - mx) * sc); acc[ai][bj][m][n][j] = e; s += e; }
                s += __shfl_xor(s, 16); s += __shfl_xor(s, 32);
                if (fq == 0) X[(ai * 128 + wr * 64 + m * 16 + fr) * 4 + wc] = (f32x2){mx, s};
                asm volatile("" ::: "memory"); }
        LDS_WAIT(); __builtin_amdgcn_s_barrier(); asm volatile("" ::: "memory");
        const int cl = u.pn * 256 + wc * 32 + 8 * fq;
#pragma unroll
        for (int ai = 0; ai < 2; ++ai)
#pragma unroll
            for (int m = 0; m < 4; ++m) { const int rl = ai * 128 + wr * 64 + m * 16 + fr; const int row = u.pm * 256 + rl;
                const f32x2 x0 = X[rl * 4 + 0], x1 = X[rl * 4 + 1], x2 = X[rl * 4 + 2], x3 = X[rl * 4 + 3];
                const float mt = fmaxf(fmaxf(x0.x, x1.x), fmaxf(x2.x, x3.x));
                const float L = x0.y * __builtin_amdgcn_exp2f((x0.x - mt) * sc) + x1.y * __builtin_amdgcn_exp2f((x1.x - mt) * sc) + x2.y * __builtin_amdgcn_exp2f((x2.x - mt) * sc) + x3.y * __builtin_amdgcn_exp2f((x3.x - mt) * sc);
                const float mo = (wc == 0) ? x0.x : (wc == 1) ? x1.x : (wc == 2) ? x2.x : x3.x;
                const float f = __builtin_amdgcn_exp2f((mo - mt) * sc) / L;
#pragma unroll
                for (int bj = 0; bj < 2; ++bj) *(v4u*)(O + (size_t)row * D + cl + bj * 128) = pack8(acc[ai][bj][m][0] * f, acc[ai][bj][m][1] * f);
                asm volatile("" ::: "memory"); }
        LDS_WAIT(); __builtin_amdgcn_s_barrier(); asm volatile("" ::: "memory");
    }
};

constexpr size_t TS = (size_t)256 * 1024 * 2;
struct SchedPlain {
    const char* A; const char* Bt; size_t ta, tb; int nM, nN, G, c;
    __device__ __forceinline__ bool next(int i, Unit& u) const {
        const long L = (long)i * G + c; if (L >= (long)nM * nN) return false;
        int pm, pn; pg8::tile_map((int)L, nM, nN, pm, pn); u.pm = pm; u.pn = pn; u.a = A + (size_t)pm * ta; u.b = Bt + (size_t)pn * tb; return true;
    }
};
struct SchedIn {
    const char* E; int G, c;
    __device__ __forceinline__ bool next(int i, Unit& u) const {
        const long L = (long)i * G + c;
        if (L < 640) { int pm, pn; pg8::tile_map((int)L, 64, 10, pm, pn); u.pm = pm; u.pn = pn; u.a = E + (size_t)pm * TS; u.b = E + (size_t)(66 + pn) * TS; return true; }
        if (L < 648) { const int x = (int)L - 640, pm = x >> 2, pn = x & 3; u.pm = pm; u.pn = 10 + pn; u.a = E + (size_t)(64 + pm) * TS; u.b = E + (size_t)(76 + pn) * TS; return true; }
        if (L < 656) { const int x = (int)L - 648, pm = x >> 1, pn = x & 1; u.pm = pm; u.pn = 14 + pn; u.a = E + (size_t)(80 + pm) * TS; u.b = E + (size_t)(64 + pn) * TS; return true; }
        return false;
    }
};
struct SchedAttn {
    const char* A; const char* B; size_t b_batch, b_head; int G, c;
    __device__ __forceinline__ bool next(int i, Unit& u) const {
        const long L = (long)i * G + c; if (L >= 256) return false;
        int pm, pn; pg8::tile_map((int)L, 64, 4, pm, pn); u.pm = pm; u.pn = pn;
        u.a = A + (size_t)pm * TS + (size_t)pn * 512; u.b = B + (size_t)(pm >> 5) * b_batch + (size_t)pn * b_head; return true;
    }
};

__device__ __forceinline__ void p0_transpose_item(const float* W, int K, int N, int k0, int s0, bf16* WT, int dst0, bool perm, const float* kscale, LAS float* scr, int lane) {
#pragma unroll 8
    for (int i = 0; i < 32; ++i) { const int kk = 2 * i + (lane >> 5); float v = W[(size_t)(k0 + kk) * N + s0 + (lane & 31)]; if (kscale) v *= kscale[k0 + kk]; scr[kk * 33 + (lane & 31)] = v; }
    LDS_WAIT(); asm volatile("" ::: "memory");
    const int c = lane & 7;
#pragma unroll
    for (int j = 0; j < 4; ++j) { const int n = (lane >> 3) + 8 * j; const LAS float* s = scr + (8 * c) * 33 + n;
        v4u o; o.x = pk2(s[0 * 33], s[1 * 33]); o.y = pk2(s[2 * 33], s[3 * 33]); o.z = pk2(s[4 * 33], s[5 * 33]); o.w = pk2(s[6 * 33], s[7 * 33]);
        const int dn = perm ? pg8::perm32(n) : n;
        *(GAS v4u*)(WT + (size_t)(dst0 + dn) * K + k0 + 8 * c) = o; }
    LDS_WAIT(); asm volatile("" ::: "memory");
}
__device__ __forceinline__ void p0_prologue(Frame& F, const Args& a) {
    unsigned char* ws = a.ws;
    LAS float* scr = (LAS float*)(F.lds + RING_OFF + F.wave * 16384);
    const int gw = F.vcu * NWAVES + F.wave, NGW = F.G * NWAVES;
    constexpr int I_IN = 16 * 80, I_SQ = 16 * 32, I_KV = 16 * 64, I_UP = 16 * 128, I_DN = 64 * 32;
    constexpr int NITEMS = I_IN + 3 * I_SQ + I_KV + I_UP + I_DN;
    for (int it = gw; it < NITEMS; it += NGW) {
        int r = it;
        if (r < I_IN) { const int kb = r / 80, nb = r % 80, s0 = 32 * nb; int dst; bool perm = false;
            if (s0 < 512) dst = 256 * (s0 >> 7) + (s0 & 127);
            else if (s0 < 1024) { const int c = s0 - 512; dst = 256 * (c >> 7) + 128 + (c & 127); }
            else { dst = s0; perm = (s0 < 1536); }
            p0_transpose_item(a.in[4], D, DIN, 64 * kb, s0, (bf16*)(ws + WS_WIN), dst, perm, a.in[3], scr, F.lane); continue; } r -= I_IN;
        if (r < I_SQ) { p0_transpose_item(a.in[10], D, D, 64 * (r / 32), 32 * (r % 32), (bf16*)(ws + WS_WOUT), 32 * (r % 32), false, nullptr, scr, F.lane); continue; } r -= I_SQ;
        if (r < I_SQ) { p0_transpose_item(a.in[13], D, D, 64 * (r / 32), 32 * (r % 32), (bf16*)(ws + WS_WQ), 32 * (r % 32), false, a.in[11], scr, F.lane); continue; } r -= I_SQ;
        if (r < I_SQ) { p0_transpose_item(a.in[15], D, D, 64 * (r / 32), 32 * (r % 32), (bf16*)(ws + WS_WO), 32 * (r % 32), false, nullptr, scr, F.lane); continue; } r -= I_SQ;
        if (r < I_KV) { p0_transpose_item(a.in[14], D, 2 * D, 64 * (r / 64), 32 * (r % 64), (bf16*)(ws + WS_WKV), 32 * (r % 64), false, nullptr, scr, F.lane); continue; } r -= I_KV;
        if (r < I_UP) { p0_transpose_item(a.in[17], D, FF, 64 * (r / 128), 32 * (r % 128), (bf16*)(ws + WS_WUP), 32 * (r % 128), false, a.in[16], scr, F.lane); continue; } r -= I_UP;
        p0_transpose_item(a.in[18], FF, D, 64 * (r / 32), 32 * (r % 32), (bf16*)(ws + WS_WDN), 32 * (r % 32), false, nullptr, scr, F.lane);
    }
    for (int m = gw; m < M + MROWS; m += NGW) {
        const bool ismem = (m >= M);
        const float* src = ismem ? a.in[1] + (size_t)(m - M) * D : a.in[0] + (size_t)m * D;
        const GAS f32x4* xr = (const GAS f32x4*)src + F.lane;
        f32x4 v[4]; float s = 0.f;
#pragma unroll
        for (int j = 0; j < 4; ++j) { v[j] = xr[64 * j]; s += (v[j].x * v[j].x + v[j].y * v[j].y) + (v[j].z * v[j].z + v[j].w * v[j].w); }
        const float rstd = 1.0f / sqrtf(wave_sum(s) * (1.0f / D) + EPS);
        bf16* dst = ismem ? (bf16*)(ws + WS_MEMN) + (size_t)(m - M) * D : (bf16*)(ws + WS_XB) + (size_t)m * D;
        GAS unsigned long long* o8 = (GAS unsigned long long*)dst + F.lane;
        if (ismem) {
            const GAS f32x4* wr = (const GAS f32x4*)a.in[12] + F.lane;
#pragma unroll
            for (int j = 0; j < 4; ++j) { const f32x4 w = wr[64 * j]; v[j] = v[j] * rstd * w; }
        } else if (F.lane == 0) ((float*)(ws + WS_RS0))[m] = rstd;
#pragma unroll
        for (int j = 0; j < 4; ++j) o8[64 * j] = (unsigned long long)pk2(v[j].x, v[j].y) | ((unsigned long long)pk2(v[j].z, v[j].w) << 32);
    }
    {
        const int* pos = (const int*)a.in[2]; float* ct = (float*)(ws + WS_COS); float* st = (float*)(ws + WS_SIN);
        for (int idx = F.vcu * 512 + F.tid; idx < M * 16; idx += F.G * 512) {
            const int row = idx >> 4, i = idx & 15;
            const float ang = (float)pos[row] * a.inv_freq[i];
            double rev = (double)ang * 0.15915494309189535; rev -= __builtin_rint(rev);
            const float rf = (float)rev;
            ct[idx] = __builtin_amdgcn_cosf(rf); st[idx] = __builtin_amdgcn_sinf(rf);
        }
    }
}

typedef float f32x16 __attribute__((ext_vector_type(16)));
typedef short bf16x8 __attribute__((ext_vector_type(8)));
typedef short s16x4 __attribute__((ext_vector_type(4)));
typedef short v4i16_t __attribute__((ext_vector_type(4)));
__device__ __forceinline__ s16x4 tr16(LAS const unsigned char* p) { return __builtin_bit_cast(s16x4, __builtin_amdgcn_ds_read_tr16_b64_v4i16((LAS v4i16_t*)p)); }
__device__ __forceinline__ bf16x8 cat8(s16x4 lo, s16x4 hi) { return (bf16x8){lo[0], lo[1], lo[2], lo[3], hi[0], hi[1], hi[2], hi[3]}; }
__device__ __forceinline__ bf16x8 pack_frag(float a0, float a1, float a2, float a3, float a4, float a5, float a6, float a7) {
    v4u w; w.x = pg8::cvt_pk_bf16(a0, a1); w.y = pg8::cvt_pk_bf16(a2, a3); w.z = pg8::cvt_pk_bf16(a4, a5); w.w = pg8::cvt_pk_bf16(a6, a7); return __builtin_bit_cast(bf16x8, w); }
__device__ __forceinline__ void stage_v(const bf16* V, size_t row0, int h, int lane, LAS unsigned char* vimg) {
#pragma unroll
    for (int t = 0; t < 8; ++t) { const int row = (lane >> 3) + 8 * t, ch = lane & 7;
        const v4u w = *(const GAS v4u*)(V + (row0 + row) * 512 + h * 64 + ch * 8);
        *(LAS v4u*)(vimg + row * 128 + ch * 16) = w; }
}
__device__ __forceinline__ bf16x8 vT_frag(LAS const unsigned char* vimg, int lanebase_v, int J0, int eb) {
    const LAS unsigned char* p = vimg + lanebase_v + J0 * 128 + eb * 64;
    return cat8(tr16(p), tr16(p + 8 * 128));
}
__device__ __forceinline__ void p2_kv(Frame& F, const Args& a) {
    const bf16* QK = (const bf16*)(a.ws + WS_QK); const bf16* V = (const bf16*)(a.ws + WS_V); float* KVT = (float*)(a.ws + WS_KVT);
    const int h = F.wave, lane = F.lane, r = lane & 31, hh = lane >> 5; const float gl2 = a.gl2[h];
    LAS unsigned char* vimg = F.lds + RING_OFF + h * 16384; LAS unsigned char* kimg = vimg + 8192;
    const int gq = lane >> 4, q_ = (lane & 15) >> 2, p_ = lane & 3;
    const int lanebase_v = (4 * (gq >> 1) + q_) * 128 + (16 * (gq & 1) + 4 * p_) * 2;
    const int lanebase_k = (4 * (gq >> 1) + q_) * 64 + (16 * (gq & 1) + 4 * p_) * 2;
    for (int gc = F.vcu; gc < NCHUNKS; gc += F.G) {
        const size_t row0 = (size_t)gc * 64;
        stage_v(V, row0, h, lane, vimg);
#pragma unroll
        for (int t = 0; t < 4; ++t) { const int row = (lane >> 2) + 16 * t, ch = lane & 3;
            const v4u w = *(const GAS v4u*)(QK + (row0 + row) * 512 + 256 + h * 32 + ch * 8);
            const float z = __builtin_amdgcn_exp2f(gl2 * (float)(63 - row));
            v4u o; o.x = pg8::cvt_pk_bf16(bflo(w.x) * z, bfhi(w.x) * z); o.y = pg8::cvt_pk_bf16(bflo(w.y) * z, bfhi(w.y) * z); o.z = pg8::cvt_pk_bf16(bflo(w.z) * z, bfhi(w.z) * z); o.w = pg8::cvt_pk_bf16(bflo(w.w) * z, bfhi(w.w) * z);
            *(LAS v4u*)(kimg + row * 64 + ch * 16) = o; }
        LDS_WAIT(); asm volatile("" ::: "memory");
        f32x16 KV0 = {}, KV1 = {};
#pragma unroll
        for (int js = 0; js < 4; ++js) { const int J0 = 16 * js;
            const LAS unsigned char* kp = kimg + lanebase_k + J0 * 64;
            const bf16x8 kzf = cat8(tr16(kp), tr16(kp + 8 * 64));
            KV0 = __builtin_amdgcn_mfma_f32_32x32x16_bf16(vT_frag(vimg, lanebase_v, J0, 0), kzf, KV0, 0, 0, 0);
            KV1 = __builtin_amdgcn_mfma_f32_32x32x16_bf16(vT_frag(vimg, lanebase_v, J0, 1), kzf, KV1, 0, 0, 0); }
        float* o = KVT + ((size_t)gc * 8 + h) * 2048 + r;
#pragma unroll
        for (int reg = 0; reg < 16; ++reg) { const int e = (reg & 3) + 8 * (reg >> 2) + 4 * hh; o[e * 32] = KV0[reg]; o[(32 + e) * 32] = KV1[reg]; }
        LDS_WAIT(); asm volatile("" ::: "memory");
    }
}
__device__ __forceinline__ void p3_scan(Frame& F, const Args& a) {
    const float* KVT = (const float*)(a.ws + WS_KVT); bf16* ST = (bf16*)(a.ws + WS_ST);
    for (int x = F.vcu * 512 + F.tid; x < BATCH * 16384; x += F.G * 512) {
        const int b = x >> 14, rem = x & 16383, h = rem >> 11; const float g = a.g64[h];
        float S = 0.f;
#pragma unroll 8
        for (int n = 0; n < NCH; ++n) { const size_t idx = ((size_t)(b * NCH + n)) * 16384 + rem; ST[idx] = (bf16)f2bf(S); S = g * S + KVT[idx]; }
    }
}
__device__ __forceinline__ void p4_ret(Frame& F, const Args& a, int gc) {
    const bf16* QK = (const bf16*)(a.ws + WS_QK); const bf16* V = (const bf16*)(a.ws + WS_V); const bf16* SG = (const bf16*)(a.ws + WS_SG);
    const bf16* ST = (const bf16*)(a.ws + WS_ST); bf16* MG = (bf16*)(a.ws + WS_RA);
    const int h = F.wave, lane = F.lane, r = lane & 31, hh = lane >> 5; const float gl2 = a.gl2[h];
    const size_t row0 = (size_t)gc * 64;
    LAS unsigned char* vimg = F.lds + RING_OFF + h * 16384;
    const int gq = lane >> 4, q_ = (lane & 15) >> 2, p_ = lane & 3;
    const int lanebase_v = (4 * (gq >> 1) + q_) * 128 + (16 * (gq & 1) + 4 * p_) * 2;
    stage_v(V, row0, h, lane, vimg);
    bf16x8 qf[2][2], kf[2][2];
#pragma unroll
    for (int b = 0; b < 2; ++b)
#pragma unroll
        for (int s = 0; s < 2; ++s) {
            qf[b][s] = *(const GAS bf16x8*)(QK + (row0 + 32 * b + r) * 512 + h * 32 + 16 * s + 8 * hh);
            kf[b][s] = *(const GAS bf16x8*)(QK + (row0 + 32 * b + r) * 512 + 256 + h * 32 + 16 * s + 8 * hh); }
    bf16x8 xb[2][2][2];
#pragma unroll
    for (int jb = 0; jb < 2; ++jb)
#pragma unroll
        for (int ib = 0; ib < 2; ++ib) {
            f32x16 X = {};
            X = __builtin_amdgcn_mfma_f32_32x32x16_bf16(kf[jb][0], qf[ib][0], X, 0, 0, 0);
            X = __builtin_amdgcn_mfma_f32_32x32x16_bf16(kf[jb][1], qf[ib][1], X, 0, 0, 0);
#pragma unroll
            for (int reg = 0; reg < 16; ++reg) { const int j = 32 * jb + (reg & 3) + 8 * (reg >> 2) + 4 * hh, i = 32 * ib + r;
                X[reg] *= __builtin_amdgcn_exp2f(gl2 * fabsf((float)(i - j))); }
            xb[jb][ib][0] = pack_frag(X[0], X[1], X[2], X[3], X[4], X[5], X[6], X[7]);
            xb[jb][ib][1] = pack_frag(X[8], X[9], X[10], X[11], X[12], X[13], X[14], X[15]);
        }
    LDS_WAIT(); asm volatile("" ::: "memory");
    f32x16 Z[2][2];
#pragma unroll
    for (int eb = 0; eb < 2; ++eb) { Z[eb][0] = (f32x16){}; Z[eb][1] = (f32x16){}; }
#pragma unroll
    for (int eb = 0; eb < 2; ++eb)
#pragma unroll
        for (int jb = 0; jb < 2; ++jb)
#pragma unroll
            for (int s = 0; s < 2; ++s) { const bf16x8 vf = vT_frag(vimg, lanebase_v, 32 * jb + 16 * s, eb);
                Z[eb][0] = __builtin_amdgcn_mfma_f32_32x32x16_bf16(vf, xb[jb][0][s], Z[eb][0], 0, 0, 0);
                Z[eb][1] = __builtin_amdgcn_mfma_f32_32x32x16_bf16(vf, xb[jb][1][s], Z[eb][1], 0, 0, 0); }
    {
        bf16x8 qp[2][2];
#pragma unroll
        for (int ib = 0; ib < 2; ++ib) { const float xi = __builtin_amdgcn_exp2f(gl2 * (float)(32 * ib + r + 1));
#pragma unroll
            for (int s = 0; s < 2; ++s) { const v4u w = __builtin_bit_cast(v4u, qf[ib][s]);
                qp[ib][s] = pack_frag(bflo(w.x) * xi, bfhi(w.x) * xi, bflo(w.y) * xi, bfhi(w.y) * xi, bflo(w.z) * xi, bfhi(w.z) * xi, bflo(w.w) * xi, bfhi(w.w) * xi); } }
#pragma unroll
        for (int eb = 0; eb < 2; ++eb)
#pragma unroll
            for (int s = 0; s < 2; ++s) { const bf16x8 sf = *(const GAS bf16x8*)(ST + (((size_t)gc * 8 + h) * 64 + 32 * eb + r) * 32 + 16 * s + 8 * hh);
                Z[eb][0] = __builtin_amdgcn_mfma_f32_32x32x16_bf16(sf, qp[0][s], Z[eb][0], 0, 0, 0);
                Z[eb][1] = __builtin_amdgcn_mfma_f32_32x32x16_bf16(sf, qp[1][s], Z[eb][1], 0, 0, 0); }
    }
#pragma unroll
    for (int ib = 0; ib < 2; ++ib) {
        float sm = 0.f;
#pragma unroll
        for (int reg = 0; reg < 16; ++reg) sm += Z[0][ib][reg] + Z[1][ib][reg];
        sm += __shfl_xor(sm, 32); const float mu = sm * (1.0f / 64.0f);
        float vr = 0.f;
#pragma unroll
        for (int reg = 0; reg < 16; ++reg) { const float d0 = Z[0][ib][reg] - mu, d1 = Z[1][ib][reg] - mu; vr += d0 * d0 + d1 * d1; }
        vr += __shfl_xor(vr, 32); const float rs = 1.0f / sqrtf(vr * (1.0f / 64.0f) + EPS);
        const size_t row = row0 + 32 * ib + r;
#pragma unroll
        for (int eb = 0; eb < 2; ++eb)
#pragma unroll
            for (int g4 = 0; g4 < 4; ++g4) { const int e0 = 32 * eb + 8 * g4 + 4 * hh;
                const f32x4 gw = *(const GAS f32x4*)(a.in[9] + h * 64 + e0);
                const unsigned long long sg = *(const GAS unsigned long long*)(SG + row * 512 + h * 64 + e0);
                const unsigned s0 = (unsigned)sg, s1 = (unsigned)(sg >> 32);
                const float o0 = (Z[eb][ib][4 * g4 + 0] - mu) * rs * gw.x * bflo(s0), o1 = (Z[eb][ib][4 * g4 + 1] - mu) * rs * gw.y * bfhi(s0);
                const float o2 = (Z[eb][ib][4 * g4 + 2] - mu) * rs * gw.z * bflo(s1), o3 = (Z[eb][ib][4 * g4 + 3] - mu) * rs * gw.w * bfhi(s1);
                *(GAS unsigned long long*)(MG + row * 1024 + 512 + h * 64 + e0) = (unsigned long long)pg8::cvt_pk_bf16(o0, o1) | ((unsigned long long)pg8::cvt_pk_bf16(o2, o3) << 32); }
    }
    LDS_WAIT(); __syncthreads();
}
__device__ __forceinline__ void p4_conv(Frame& F, const Args& a, int gc) {
    const unsigned* U2 = (const unsigned*)(a.ws + WS_U); unsigned* MG2 = (unsigned*)(a.ws + WS_RA);
    const int cp = F.tid & 255, th = F.tid >> 8; const int t0 = (gc & (NCH - 1)) * 64; const size_t rowb = (size_t)(gc >> 7) * SEQ;
    LAS float* Y = (LAS float*)(F.lds + RING_OFF);
    LAS f32x2* STt = (LAS f32x2*)(F.lds + XS_OFF);
    f32x2 w[CONVW];
#pragma unroll
    for (int j = 0; j < CONVW; ++j) w[j] = *(const GAS f32x2*)(a.in[5] + j * CCH + 2 * cp);
    const f32x2 cb = *(const GAS f32x2*)(a.in[6] + 2 * cp);
#pragma unroll 1
    for (int blk = 0; blk < 4; ++blk) {
        const int tl = th * 32 + blk * 8, tt = t0 + tl; f32x2 uu[38];
#pragma unroll
        for (int k = 0; k < 38; ++k) { const int t = tt - 30 + k; const unsigned x = (t >= 0) ? U2[(rowb + t) * 256 + cp] : 0u; uu[k] = (f32x2){bflo(x), bfhi(x)}; }
#pragma unroll
        for (int o = 0; o < 8; ++o) { f32x2 s = cb;
#pragma unroll
            for (int j = 0; j < CONVW; ++j) s += w[j] * uu[o + j];
            *(LAS f32x2*)(Y + (tl + o) * 512 + 2 * cp) = s; }
    }
    __syncthreads();
    for (int tk = 0; tk < 8; ++tk) { const int t = F.wave * 8 + tk;
        const f32x4 v0 = *(const LAS f32x4*)(Y + t * 512 + F.lane * 8), v1 = *(const LAS f32x4*)(Y + t * 512 + F.lane * 8 + 4);
        const float s = (v0.x + v0.y) + (v0.z + v0.w) + (v1.x + v1.y) + (v1.z + v1.w);
        const float mean = wave_sum(s) * (1.0f / 512.0f);
        const f32x4 d0 = v0 - mean, d1 = v1 - mean;
        const float s2 = (d0.x * d0.x + d0.y * d0.y) + (d0.z * d0.z + d0.w * d0.w) + (d1.x * d1.x + d1.y * d1.y) + (d1.z * d1.z + d1.w * d1.w);
        const float rstd = 1.0f / sqrtf(wave_sum(s2) * (1.0f / 512.0f) + EPS);
        if (F.lane == 0) STt[t] = (f32x2){mean, rstd}; }
    __syncthreads();
    const f32x2 lw = *(const GAS f32x2*)(a.in[7] + 2 * cp), lb = *(const GAS f32x2*)(a.in[8] + 2 * cp);
#pragma unroll 4
    for (int k = 0; k < 32; ++k) { const int t = th * 32 + k; const f32x2 st = STt[t]; const f32x2 y = *(const LAS f32x2*)(Y + t * 512 + 2 * cp);
        const float y0 = (y.x - st.x) * st.y * lw.x + lb.x, y1 = (y.y - st.x) * st.y * lw.y + lb.y;
        MG2[(rowb + t0 + t) * 512 + cp] = pg8::cvt_pk_bf16(y0 * fast_sigmoid(y0), y1 * fast_sigmoid(y1)); }
    __syncthreads();
}
__device__ __forceinline__ void p12_final(Frame& F, const Args& a) {
    const int gw = F.vcu * NWAVES + F.wave, NGW = F.G * NWAVES;
    const GAS f32x4* wr = (const GAS f32x4*)a.in[19] + F.lane;
    f32x4 w[4];
#pragma unroll
    for (int j = 0; j < 4; ++j) w[j] = wr[64 * j];
    for (int m = gw; m < M; m += NGW) {
        GAS f32x4* xr = (GAS f32x4*)(a.out + (size_t)m * D) + F.lane;
        f32x4 v[4]; float s = 0.f;
#pragma unroll
        for (int j = 0; j < 4; ++j) { v[j] = xr[64 * j]; s += (v[j].x * v[j].x + v[j].y * v[j].y) + (v[j].z * v[j].z + v[j].w * v[j].w); }
        const float rstd = 1.0f / sqrtf(wave_sum(s) * (1.0f / D) + EPS);
#pragma unroll
        for (int j = 0; j < 4; ++j) xr[64 * j] = v[j] * rstd * w[j];
    }
}

__global__ void __launch_bounds__(NWAVES * 64, 2) fwd_kernel(Args args) {
    extern __shared__ __attribute__((aligned(16))) unsigned char lds[];
    Frame F;
    F.lds = (LAS unsigned char*)lds;
    volatile LAS unsigned* MISC = (volatile LAS unsigned*)(F.lds + MISC_OFF);
    F.tid = threadIdx.x; F.lane = F.tid & 63; F.wave = __builtin_amdgcn_readfirstlane(F.tid >> 6);
    F.G = gridDim.x; { const int bx = blockIdx.x; F.vcu = (F.G % 8 == 0) ? (bx % 8) * (F.G / 8) + bx / 8 : bx; }
    unsigned char* ws = args.ws;
    gu32* ctl = (gu32*)(ws + WS_CTL);
    for (int u = F.tid; u < 256; u += NWAVES * 64) ((LAS unsigned*)(F.lds + LDSCTL_OFF))[u] = 0u;
    __syncthreads();
    XcdBarrier bar; bar.bar = (unsigned*)(ctl + CW_BAR); bar.x = 0; bar.st = nullptr;
    if (N_LAUNCHES == 1) bar = xcd_barrier_post((unsigned*)(ctl + CW_BAR), MISC + 8);
#define GRID_BAR() do { if (N_LAUNCHES == 1) xcd_barrier(bar); } while (0)
    const int lo = args.ph_lo, hi = args.ph_hi;
#define IN(k) (lo <= (k) && (k) < hi)
    const int c = (int)blockIdx.x;
    LAS unsigned char* ring = F.lds + RING_OFF;
    float* rss1 = (float*)(ws + WS_CTL + CTL_RSS1); float* rss2 = (float*)(ws + WS_CTL + CTL_RSS2);

    if (IN(0)) { p0_prologue(F, args); GRID_BAR(); }
    if (IN(1)) {
        SchedIn S{(const char*)(ws + WS_E), F.G, c};
        EpiIn E{(bf16*)(ws + WS_U), (bf16*)(ws + WS_QK), (bf16*)(ws + WS_V), (bf16*)(ws + WS_SG), (bf16*)(ws + WS_KMEM), (bf16*)(ws + WS_VT), (const float*)(ws + WS_RS0), (const float*)(ws + WS_COS), (const float*)(ws + WS_SIN)};
        pg8::gemm_phase(ring, pg8::Shape{D, D, D}, S, E);
        GRID_BAR();
    }
    if (IN(2)) { p2_kv(F, args); GRID_BAR(); }
    if (IN(3)) { p3_scan(F, args); GRID_BAR(); }
    if (IN(4)) {
        for (int u = F.vcu; u < NCHUNKS; u += F.G) p4_conv(F, args, u);
        for (int u = F.vcu; u < NCHUNKS; u += F.G) p4_ret(F, args, u);
        GRID_BAR();
    }
    if (IN(5)) {
        SchedPlain S{(const char*)(ws + WS_RA), (const char*)(ws + WS_WOUT), TS, TS, 64, 4, F.G, c};
        EpiRes E{args.in[0], args.out, (bf16*)(ws + WS_HB), rss1};
        pg8::gemm_phase(ring, pg8::Shape{D, D, D}, S, E);
        GRID_BAR();
    }
    if (IN(6)) {
        SchedPlain S{(const char*)(ws + WS_HB), (const char*)(ws + WS_WQ), TS, TS, 64, 4, F.G, c};
        EpiScale<0> E{(bf16*)(ws + WS_RA), D, rss1};
        pg8::gemm_phase(ring, pg8::Shape{D, D, D}, S, E);
        GRID_BAR();
    }
    if (IN(7)) {
        SchedAttn S{(const char*)(ws + WS_RA), (const char*)(ws + WS_KMEM), (size_t)256 * 1024 * 2, (size_t)512, F.G, c};
        EpiSoftmax E{(bf16*)(ws + WS_P)};
        pg8::gemm_phase(ring, pg8::Shape{256, D, D}, S, E);
        GRID_BAR();
    }
    if (IN(8)) {
        SchedAttn S{(const char*)(ws + WS_P), (const char*)(ws + WS_VT), (size_t)512, (size_t)256 * 512 * 2, F.G, c};
        EpiPlain E{(bf16*)(ws + WS_RA), D};
        pg8::gemm_phase(ring, pg8::Shape{256, D, 512}, S, E);
        GRID_BAR();
    }
    if (IN(9)) {
        SchedPlain S{(const char*)(ws + WS_RA), (const char*)(ws + WS_WO), TS, TS, 64, 4, F.G, c};
        EpiRes E{args.out, args.out, (bf16*)(ws + WS_HB), rss2};
        pg8::gemm_phase(ring, pg8::Shape{D, D, D}, S, E);
        GRID_BAR();
    }
    if (IN(10)) {
        SchedPlain S{(const char*)(ws + WS_HB), (const char*)(ws + WS_WUP), TS, TS, 64, 16, F.G, c};
        EpiScale<1> E{(bf16*)(ws + WS_HID), FF, rss2};
        pg8::gemm_phase(ring, pg8::Shape{D, D, D}, S, E);
        GRID_BAR();
    }
    if (IN(11)) {
        SchedPlain S{(const char*)(ws + WS_HID), (const char*)(ws + WS_WDN), (size_t)256 * FF * 2, (size_t)256 * FF * 2, 64, 4, F.G, c};
        EpiRes E{args.out, args.out, nullptr, nullptr};
        pg8::gemm_phase(ring, pg8::Shape{FF, FF, FF}, S, E);
        GRID_BAR();
    }
    if (IN(12)) { p12_final(F, args); }
#undef IN
#undef GRID_BAR
}

extern "C" void kernel_launch(void* const* d_in, const int* in_sizes, int n_in, void* d_out, int out_size, void* d_ws, size_t ws_size, hipStream_t stream) {
    static int grid = 0;
    if (grid == 0) {
        if (n_in != 20 || in_sizes[0] != M * D || out_size != M * D || ws_size < WS_END) { fprintf(stderr, "kernel_launch: unexpected problem shape (n_in %d, in0 %d, out %d, ws %zu); nothing launched\n", n_in, n_in > 0 ? in_sizes[0] : -1, out_size, ws_size); grid = -1; return; }
        int dev = 0, cus = 0;
        if (hipGetDevice(&dev) != hipSuccess || hipDeviceGetAttribute(&cus, hipDeviceAttributeMultiprocessorCount, dev) != hipSuccess) { grid = -1; return; }
        if (hipFuncSetAttribute((const void*)fwd_kernel, hipFuncAttributeMaxDynamicSharedMemorySize, LDS_BYTES) != hipSuccess) { fprintf(stderr, "kernel_launch: hipFuncSetAttribute failed\n"); grid = -1; return; }
        int per_cu = 0;
        if (hipOccupancyMaxActiveBlocksPerMultiprocessor(&per_cu, (const void*)fwd_kernel, NWAVES * 64, LDS_BYTES) != hipSuccess || per_cu < 1)
            fprintf(stderr, "kernel_launch: note: occupancy query reports %d workgroups per CU\n", per_cu);
        (void)hipGetLastError();
        grid = cus;
    }
    if (grid < 0) return;
    if (hipMemsetAsync((char*)d_ws + WS_CTL, 0, CTL_ZERO_BYTES, stream) != hipSuccess) { fprintf(stderr, "kernel_launch: hipMemsetAsync failed\n"); return; }
    Args a{};
    for (int i = 0; i < 20; ++i) a.in[i] = (const float*)d_in[i];
    a.out = (float*)d_out; a.ws = (unsigned char*)d_ws;
    for (int i = 0; i < 16; ++i) a.inv_freq[i] = (float)std::pow(10000.0, -(double)i / 16.0);
    for (int h = 0; h < 8; ++h) { const double lg = std::log1p(-std::exp2(-5.0 - (double)h)); a.gl2[h] = (float)(lg / std::log(2.0)); a.g64[h] = (float)std::exp(64.0 * lg); }
    for (int li = 0; li < N_LAUNCHES; ++li) {
        a.ph_lo = (N_LAUNCHES == 1) ? 0 : li; a.ph_hi = (N_LAUNCHES == 1) ? N_PHASES : li + 1; a.li = li;
        hipLaunchKernelGGL(fwd_kernel, dim3(grid), dim3(NWAVES * 64), LDS_BYTES, stream, a);
        const hipError_t le = hipPeekAtLastError();
        if (le != hipSuccess) { fprintf(stderr, "kernel_launch: launch %d failed: %s\n", li, hipGetErrorName(le)); break; }
    }
}
```
